# Optimizing an MI355X kernel written in HIP

```python
import jax, jax.numpy as jnp
from jax import lax
import numpy as np

D_MODEL = 2048
BATCH = 2
SEQ = 8192
DEPTH = 4

HEAD_DIM = 128
GRID_W = 64
BLOCK = 128
EPS = 1e-6
NEG_INF = -1e30
NA_HEADS = 8
NA_WIN_R = 8
NA_WIN_C = 16
GQ_HEADS = 8
GKV_HEADS = 2
ROPE_BASE = 10000.0
DIL_GROUPS = ((128, 1), (512, 4), (2048, 16))
DIL_HEADS_PER_GROUP = 4
DIL_HEADS = 12
ALIBI_MAX_EXP = 8.0
WA = NA_HEADS * HEAD_DIM
WB_Q = GQ_HEADS * HEAD_DIM
WB_KV = GKV_HEADS * HEAD_DIM
WC = DIL_HEADS * HEAD_DIM
WC_OUT = DIL_HEADS_PER_GROUP * HEAD_DIM
SPLIT_SIZES = (WA, WA, WA, WB_Q, WB_KV, WB_KV, WC, WC, WC, WA, WB_Q, WC_OUT, 3 * D_MODEL)
N_IN = WA * 4 + WB_Q * 2 + WB_KV * 2 + WC * 3 + WC_OUT + 3 * D_MODEL

kernel_name = "hybrid_gated_parallel_encoder"


def rmsnorm(x, g):
    x32 = x.astype(jnp.float32)
    y = x32 * lax.rsqrt(jnp.mean(x32 * x32, axis=-1, keepdims=True) + EPS)
    return (y * g.astype(jnp.float32)).astype(x.dtype)


def rope_1d(x, pos):
    half = x.shape[-1] // 2
    freqs = ROPE_BASE ** (-jnp.arange(half, dtype=jnp.float32) / half)
    ang = pos.astype(jnp.float32)[:, None] * freqs[None, :]
    cos = jnp.cos(ang)[None, :, None, :].astype(x.dtype)
    sin = jnp.sin(ang)[None, :, None, :].astype(x.dtype)
    x1, x2 = x[..., :half], x[..., half:]
    return jnp.concatenate([x1 * cos - x2 * sin, x1 * sin + x2 * cos], axis=-1)


def axial_rope(x):
    t = jnp.arange(x.shape[1])
    half = x.shape[-1] // 2
    return jnp.concatenate([rope_1d(x[..., :half], t // GRID_W),
                            rope_1d(x[..., half:], t % GRID_W)], axis=-1)


def neighbourhood_attention(q, k, v, rpb):
    bsz, seq, heads, e = q.shape
    rows = seq // GRID_W
    kr = min(NA_WIN_R, rows)
    qg = q.reshape(bsz, rows, GRID_W, heads, e)
    kg = k.reshape(bsz, rows, GRID_W, heads, e)
    vg = v.reshape(bsz, rows, GRID_W, heads, e)
    j = jnp.arange(GRID_W)
    c = jnp.arange(GRID_W)
    cs = jnp.clip(j - NA_WIN_C // 2, 0, GRID_W - NA_WIN_C)
    col_ok = (c[None, :] >= cs[:, None]) & (c[None, :] < cs[:, None] + NA_WIN_C)
    dc_idx = jnp.clip(c[None, :] - j[:, None] + NA_WIN_C - 1, 0, 2 * NA_WIN_C - 2)
    scale = e ** -0.5

    def row_block(r):
        start = jnp.clip(r - kr // 2, 0, rows - kr)
        q_r = lax.dynamic_index_in_dim(qg, r, axis=1, keepdims=False)
        k_r = lax.dynamic_slice_in_dim(kg, start, kr, axis=1)
        v_r = lax.dynamic_slice_in_dim(vg, start, kr, axis=1)
        dr_idx = start + jnp.arange(kr) - r + NA_WIN_R - 1
        bias = rpb[:, dr_idx[None, :, None], dc_idx[:, None, :]]
        s = jnp.einsum('bjhe,bkche->bhjkc', q_r, k_r,
                       preferred_element_type=jnp.float32) * scale + bias.astype(jnp.float32)[None]
        s = jnp.where(col_ok[:, None, :], s, NEG_INF)
        p = jax.nn.softmax(s.reshape(bsz, heads, GRID_W, kr * GRID_W), axis=-1).reshape(s.shape)
        return jnp.einsum('bhjkc,bkche->bjhe', p.astype(v.dtype), v_r)

    o = lax.map(row_block, jnp.arange(rows))
    return o.transpose(1, 0, 2, 3, 4).reshape(bsz, seq, heads * e)


def gqa_attention(q, k, v):
    bsz, seq, hq, e = q.shape
    hkv = k.shape[2]
    grp = hq // hkv
    nb = seq // BLOCK
    scale = e ** -0.5
    qb = q.reshape(bsz, nb, BLOCK, hkv, grp, e).transpose(1, 0, 2, 3, 4, 5)

    def block(qi):
        s = jnp.einsum('bqkge,bske->bkgqs', qi, k, preferred_element_type=jnp.float32) * scale
        p = jax.nn.softmax(s, axis=-1)
        return jnp.einsum('bkgqs,bske->bqkge', p.astype(v.dtype), v)

    o = lax.map(block, qb)
    return o.transpose(1, 0, 2, 3, 4, 5).reshape(bsz, seq, hq * e)


def dilated_group(q, k, v, dil, reach, slopes):
    bsz, seq, hg, e = q.shape
    length = seq // dil
    nb = -(-length // BLOCK)
    lp = nb * BLOCK
    kb_len = BLOCK + 2 * reach
    scale = e ** -0.5

    def to_sub(t):
        return t.reshape(bsz, length, dil, hg, e).transpose(0, 2, 3, 1, 4)

    qs = jnp.pad(to_sub(q), ((0, 0), (0, 0), (0, 0), (0, lp - length), (0, 0)))
    qs = qs.reshape(bsz, dil, hg, nb, BLOCK, e)
    pad_kv = ((0, 0), (0, 0), (0, 0), (reach, lp - length + reach), (0, 0))
    ks = jnp.pad(to_sub(k), pad_kv)
    vs = jnp.pad(to_sub(v), pad_kv)
    idx = jnp.arange(nb)[:, None] * BLOCK + jnp.arange(kb_len)[None, :]
    kbk = ks[:, :, :, idx]
    kbv = vs[:, :, :, idx]
    lq = jnp.arange(nb)[:, None] * BLOCK + jnp.arange(BLOCK)[None, :]
    lk = idx - reach
    dist = jnp.abs(lq[:, :, None] - lk[:, None, :])
    valid = (dist <= reach) & ((lk >= 0) & (lk < length))[:, None, :]
    s = jnp.einsum('bdhnqe,bdhnke->bdhnqk', qs, kbk, preferred_element_type=jnp.float32) * scale
    s = s - slopes[:, None, None, None] * (dil * dist).astype(jnp.float32)
    s = jnp.where(valid, s, NEG_INF)
    lse = jax.nn.logsumexp(s, axis=-1)
    p = jnp.exp(s - lse[..., None])
    o = jnp.einsum('bdhnqk,bdhnke->bdhnqe', p.astype(v.dtype), kbv)
    o = o.reshape(bsz, dil, hg, lp, e)[:, :, :, :length]
    o = o.transpose(0, 3, 1, 2, 4).reshape(bsz, seq, hg, e)
    lse = lse.reshape(bsz, dil, hg, lp)[..., :length].transpose(0, 3, 1, 2).reshape(bsz, seq, hg)
    return o, lse


def dilated_mixture(q, k, v):
    bsz, seq = q.shape[0], q.shape[1]
    slopes = 2.0 ** (-ALIBI_MAX_EXP * jnp.arange(1, DIL_HEADS + 1, dtype=jnp.float32) / DIL_HEADS)
    outs, lses = [], []
    for g, (win, dil) in enumerate(DIL_GROUPS):
        sl = slice(g * DIL_HEADS_PER_GROUP, (g + 1) * DIL_HEADS_PER_GROUP)
        o, l = dilated_group(q[:, :, sl], k[:, :, sl], v[:, :, sl], dil, (win // 2) // dil, slopes[sl])
        outs.append(o)
        lses.append(l)
    wts = jax.nn.softmax(jnp.stack(lses, axis=-1), axis=-1)
    o = jnp.sum(jnp.stack(outs, axis=3) * wts[..., None].astype(q.dtype), axis=3)
    return o.reshape(bsz, seq, WC_OUT)


def setup_inputs(seed: int = 0) -> dict:
    key = jax.random.key(seed)
    ks = jax.random.split(key, 12)
    f32 = jnp.float32
    return {
        "x": jax.random.normal(ks[0], (BATCH, SEQ, D_MODEL), f32),
        "pre_norm_g": 1.0 + 0.02 * jax.random.normal(ks[1], (DEPTH, D_MODEL), f32),
        "w_in": jax.random.normal(ks[2], (DEPTH, D_MODEL, N_IN), f32) * D_MODEL ** -0.5,
        "b_gate": 0.1 * jax.random.normal(ks[3], (DEPTH, 3 * D_MODEL), f32),
        "q_norm_g": 1.0 + 0.02 * jax.random.normal(ks[4], (DEPTH, HEAD_DIM), f32),
        "k_norm_g": 1.0 + 0.02 * jax.random.normal(ks[5], (DEPTH, HEAD_DIM), f32),
        "rpb": 0.1 * jax.random.normal(ks[6], (DEPTH, NA_HEADS, 2 * NA_WIN_R - 1, 2 * NA_WIN_C - 1), f32),
        "w_branch_a": jax.random.normal(ks[7], (DEPTH, WA, D_MODEL), f32) * WA ** -0.5,
        "w_branch_b": jax.random.normal(ks[8], (DEPTH, WB_Q, D_MODEL), f32) * WB_Q ** -0.5,
        "w_branch_c": jax.random.normal(ks[9], (DEPTH, WC_OUT, D_MODEL), f32) * WC_OUT ** -0.5,
        "w_out": jax.random.normal(ks[10], (DEPTH, D_MODEL, D_MODEL), f32) * D_MODEL ** -0.5,
        "post_norm_g": 1.0 + 0.02 * jax.random.normal(ks[11], (DEPTH, D_MODEL), f32),
    }


def reference(x, pre_norm_g, w_in, b_gate, q_norm_g, k_norm_g, rpb, w_branch_a, w_branch_b,
              w_branch_c, w_out, post_norm_g):
    bsz, seq = x.shape[0], x.shape[1]
    split_points = [int(p) for p in np.cumsum(SPLIT_SIZES)[:-1]]

    def heads(t, n):
        return t.reshape(bsz, seq, n, HEAD_DIM)

    for l in range(DEPTH):
        h = rmsnorm(x, pre_norm_g[l])
        proj = jnp.einsum('bsd,dn->bsn', h, w_in[l])
        (qa, ka, va, qb, kb, vb, qc, kc, vc, za, zb, zc, gates) = jnp.split(proj, split_points, axis=-1)
        ya = neighbourhood_attention(heads(qa, NA_HEADS), heads(ka, NA_HEADS), heads(va, NA_HEADS), rpb[l])
        qb_h = axial_rope(rmsnorm(heads(qb, GQ_HEADS), q_norm_g[l]))
        kb_h = axial_rope(rmsnorm(heads(kb, GKV_HEADS), k_norm_g[l]))
        yb = gqa_attention(qb_h, kb_h, heads(vb, GKV_HEADS))
        yc = dilated_mixture(heads(qc, DIL_HEADS), heads(kc, DIL_HEADS), heads(vc, DIL_HEADS))
        g = jax.nn.sigmoid((gates + b_gate[l]).astype(jnp.float32)).astype(x.dtype)
        ga, gb, gc = jnp.split(g, 3, axis=-1)
        merged = (ga * jnp.einsum('bsw,wd->bsd', ya * jax.nn.silu(za), w_branch_a[l])
                  + gb * jnp.einsum('bsw,wd->bsd', yb * jax.nn.silu(zb), w_branch_b[l])
                  + gc * jnp.einsum('bsw,wd->bsd', yc * jax.nn.silu(zc), w_branch_c[l]))
        out = jnp.einsum('bsd,de->bse', merged, w_out[l])
        x = x + rmsnorm(out, post_norm_g[l])
    return x
```

```cpp
#include <hip/hip_runtime.h>
#include <hip/hip_cooperative_groups.h>
#include <cstdio>
#include <cstdint>
namespace cg = cooperative_groups;

#ifndef PHMASK
#define PHMASK 0xff
#endif
#ifndef P2MASK
#define P2MASK 7
#endif
#ifndef PROBE_SUB
#define PROBE_SUB -1
#endif
#ifndef NA_SD
#define NA_SD 1
#endif
#ifndef NA_SIMPLE
#define NA_SIMPLE true
#endif
#ifndef DIL_SD
#define DIL_SD 1
#endif
#ifndef DIL_SIMPLE
#define DIL_SIMPLE true
#endif
#ifndef MK_ONE_LAUNCH
#define MK_ONE_LAUNCH 1
#endif

#define LAS __attribute__((address_space(3)))
typedef unsigned short bf16_t;
typedef short bf16x8 __attribute__((ext_vector_type(8)));
typedef short s16x4 __attribute__((ext_vector_type(4)));
typedef float f32x4 __attribute__((ext_vector_type(4)));
typedef float f32x16 __attribute__((ext_vector_type(16)));
typedef unsigned u32x4 __attribute__((ext_vector_type(4)));
typedef unsigned u32x2 __attribute__((ext_vector_type(2)));

constexpr int NB = 2, SEQ = 8192, MT = NB * SEQ, DM = 2048, NIN = 17920, DEPTH = 4, YW = 2560;
constexpr int C_QA = 0, C_KA = 1024, C_VA = 2048, C_QB = 3072, C_QC = 4608, C_KC = 6144, C_VC = 7680, C_ZA = 9216, C_ZB = 10240, C_ZC = 11264, C_G = 11776;
constexpr float EPS = 1e-6f;
constexpr size_t al256(size_t x) { return (x + 255) / 256 * 256; }
constexpr size_t WS_WIN = 0;
constexpr size_t WS_WBR = WS_WIN + al256((size_t)DEPTH * NIN * DM * 2);
constexpr size_t WS_WOUT = WS_WBR + al256((size_t)DEPTH * DM * YW * 2);
constexpr size_t WS_H = WS_WOUT + al256((size_t)DEPTH * DM * DM * 2);
constexpr size_t WS_PROJ = WS_H + al256((size_t)MT * DM * 2);
constexpr size_t WS_Y = WS_PROJ + al256((size_t)MT * NIN * 2);
constexpr size_t WS_QB = WS_Y + al256((size_t)MT * YW * 2);
constexpr size_t WS_KB = WS_QB + al256((size_t)MT * 1024 * 2);
constexpr size_t WS_VB = WS_KB + al256((size_t)MT * 256 * 2);
constexpr size_t WS_OC = WS_VB + al256((size_t)MT * 256 * 2);
constexpr size_t WS_LSE = WS_OC + al256((size_t)3 * MT * 512 * 2);
constexpr size_t WS_MRG = WS_LSE + al256((size_t)3 * MT * 4 * 4);
constexpr size_t WS_OUT = WS_MRG + al256((size_t)MT * DM * 2);
constexpr size_t WS_GF = WS_OUT + al256((size_t)MT * DM * 4);
constexpr size_t WS_BAR = WS_GF + al256((size_t)3 * MT * DM * 2);
constexpr size_t WS_END = WS_BAR + 16384;

typedef __bf16 bf16x2_t __attribute__((ext_vector_type(2)));
typedef float f32x2_t __attribute__((ext_vector_type(2)));
__device__ __forceinline__ unsigned cvt_pk_bf16(float lo, float hi) { f32x2_t v = {lo, hi}; bf16x2_t r = __builtin_convertvector(v, bf16x2_t); return __builtin_bit_cast(unsigned, r); }
__device__ __forceinline__ float bf_lo(unsigned w) { return __uint_as_float(w << 16); }
__device__ __forceinline__ float bf_hi(unsigned w) { return __uint_as_float(w & 0xffff0000u); }
__device__ __forceinline__ float bf2f(bf16_t v) { return __uint_as_float(((unsigned)v) << 16); }
__device__ __forceinline__ int opaque_v(int v) { asm volatile("" : "+v"(v)); return v; }
__device__ __forceinline__ int opaque_si(int v) { asm volatile("" : "+s"(v)); return v; }
template <class T> __device__ __forceinline__ T* opaque_s(T* p) { asm volatile("" : "+s"(p)); return p; }
__device__ __forceinline__ float sigmoidf_(float v) { return __builtin_amdgcn_rcpf(1.0f + __builtin_amdgcn_exp2f(-1.4426950408889634f * v)); }

namespace pg8 {
constexpr int BM = 256, BK = 64, HALF = 128, HTB = HALF * BK * 2, STAGE_BYTES = 8 * HTB, NXCD = 8, WGM = 8;
__host__ __device__ __forceinline__ int lds_byte(int r, int c) { const int st = (r >> 4) * 2 + (c >> 5), rr = r & 15, cc = c & 31, ob = rr * 64 + cc * 2; return st * 1024 + (ob ^ (((ob >> 9) & 1) << 5)); }
__host__ __device__ __forceinline__ void stage_rc(int b, int& R, int& C) { const int st = b / 1024, sb = b % 1024, swz = sb ^ (((sb >> 9) & 1) << 5); R = (st >> 1) * 16 + swz / 64; C = (st & 1) * 32 + (swz % 64) / 2; }
__host__ __device__ __forceinline__ int perm32(int rho) { const int n = rho >> 4, i = rho & 15; return 8 * (i >> 2) + 4 * n + (i & 3); }
struct Unit { int pm, pn; };
struct Gemm { const bf16_t* A; const bf16_t* Bt; int M, N, K, lda, ldb; };
struct StaticOrder {
    int nM, nN, nwg, G, c;
    __device__ void init(int M, int N, int G_, int c_) { nM = M / BM; nN = N / BM; nwg = nM * nN; G = G_; c = c_; }
    __device__ bool next(int i, Unit& u) const {
        const long L = (long)i * G + c; if (L >= nwg) return false;
        int wgid = (int)L; { const int q = nwg / NXCD, r = nwg % NXCD, xcd = wgid % NXCD, off = wgid / NXCD; wgid = (xcd < r ? xcd * (q + 1) : r * (q + 1) + (xcd - r) * q) + off; }
        const int nig = WGM * nN, gid = wgid / nig, fm = gid * WGM, gsz = (nM - fm) < WGM ? (nM - fm) : WGM;
        u.pm = fm + ((wgid % nig) % gsz); u.pn = (wgid % nig) / gsz; return true;
    }
};
struct EpiProj {
    static constexpr bool PERM = true, HAS_MID = false;
    bf16_t* O; const float* bgate; u32x4* GF;
    __device__ __forceinline__ void mid(f32x4 (&)[2][2][4][2], const Unit&, int, int, int, int, int) const {}
    __device__ __forceinline__ void operator()(const f32x4 (&acc)[2][2][4][2], const Unit& u, int wr, int wc, int fr, int fq) const {
        fr = opaque_v(fr); fq = opaque_v(fq);
        const int row0 = u.pm * BM + wr * 64 + fr, colt = u.pn * BM, col0 = colt + wc * 32 + 8 * fq;
        const int mode = colt < C_ZA ? 0 : (colt < C_G ? 1 : 2);
        if (mode == 2) {
            const int gt = u.pn - C_G / BM;
            u32x4* gf = GF + ((size_t)(((gt >> 3) * 64 + u.pm) * 8 + (gt & 7)) * 8 + (wr * 4 + wc)) * 1024 + fq * 16 + fr;
            f32x4 bv[2][2];
#pragma unroll
            for (int bj = 0; bj < 2; ++bj)
#pragma unroll
                for (int n = 0; n < 2; ++n) bv[bj][n] = *(const f32x4*)(bgate + (col0 - C_G) + bj * HALF + 4 * n);
#pragma unroll
            for (int ai = 0; ai < 2; ++ai)
#pragma unroll
                for (int m = 0; m < 4; ++m)
#pragma unroll
                    for (int bj = 0; bj < 2; ++bj) { const f32x4 v0 = acc[ai][bj][m][0] + bv[bj][0], v1 = acc[ai][bj][m][1] + bv[bj][1];
                        u32x4 w; w.x = cvt_pk_bf16(sigmoidf_(v0[0]), sigmoidf_(v0[1])); w.y = cvt_pk_bf16(sigmoidf_(v0[2]), sigmoidf_(v0[3]));
                        w.z = cvt_pk_bf16(sigmoidf_(v1[0]), sigmoidf_(v1[1])); w.w = cvt_pk_bf16(sigmoidf_(v1[2]), sigmoidf_(v1[3]));
                        gf[((ai * 4 + m) * 2 + bj) * 64] = w; }
            return;
        }
#pragma unroll
        for (int ai = 0; ai < 2; ++ai)
#pragma unroll
            for (int m = 0; m < 4; ++m) { bf16_t* rowp = O + (size_t)(row0 + ai * HALF + m * 16) * NIN + col0;
#pragma unroll
                for (int bj = 0; bj < 2; ++bj) { f32x4 v0 = acc[ai][bj][m][0], v1 = acc[ai][bj][m][1];
                    if (mode != 0) {
#pragma unroll
                        for (int j = 0; j < 4; ++j) { v0[j] *= sigmoidf_(v0[j]); v1[j] *= sigmoidf_(v1[j]); }
                    }
                    u32x4 w; w.x = cvt_pk_bf16(v0[0], v0[1]); w.y = cvt_pk_bf16(v0[2], v0[3]); w.z = cvt_pk_bf16(v1[0], v1[1]); w.w = cvt_pk_bf16(v1[2], v1[3]);
                    *(u32x4*)(rowp + bj * HALF) = w; } }
    }
};
struct EpiMerged {
    static constexpr bool PERM = true, HAS_MID = true;
    const u32x4* GF;
    bf16_t* O;
    __device__ __forceinline__ const u32x4* gbase(int gate, const Unit& u, int wr, int wc, int fr, int fq) const {
        return GF + ((size_t)((gate * 64 + u.pm) * 8 + u.pn) * 8 + (wr * 4 + wc)) * 1024 + fq * 16 + fr; }
    __device__ __forceinline__ void mid(f32x4 (&acc)[2][2][4][2], const Unit& u, int t, int wr, int wc, int fr, int fq) const {
        fr = opaque_v(fr); fq = opaque_v(fq);
        const int gn = (t == 16) ? 0 : 1;
        const u32x4* pa = gbase(gn, u, wr, wc, fr, fq); const u32x4* pb = gbase(gn + 1, u, wr, wc, fr, fq);
        u32x4 a0[4], b0[4], a1[4], b1[4];
#define GF_LD(A, B, H) _Pragma("unroll") for (int k = 0; k < 4; ++k) { A[k] = pa[((H) * 4 + k) * 64]; B[k] = pb[((H) * 4 + k) * 64]; }
#define GF_USE(A, B, H) _Pragma("unroll") for (int k = 0; k < 4; ++k) { const int f = (H) * 4 + k, ai = f >> 3, m = (f >> 1) & 3, bj = f & 1; \
            _Pragma("unroll") for (int q = 0; q < 4; ++q) { const float r0 = bf_lo(A[k][q]) * __builtin_amdgcn_rcpf(fmaxf(bf_lo(B[k][q]), 1e-30f)), r1 = bf_hi(A[k][q]) * __builtin_amdgcn_rcpf(fmaxf(bf_hi(B[k][q]), 1e-30f)); \
                acc[ai][bj][m][q >> 1][(q & 1) * 2] *= r0; acc[ai][bj][m][q >> 1][(q & 1) * 2 + 1] *= r1; } }
        GF_LD(a0, b0, 0) GF_LD(a1, b1, 1)
        asm volatile("" ::: "memory");
        GF_USE(a0, b0, 0) GF_LD(a0, b0, 2)
        asm volatile("" ::: "memory");
        GF_USE(a1, b1, 1) GF_LD(a1, b1, 3)
        asm volatile("" ::: "memory");
        GF_USE(a0, b0, 2)
        GF_USE(a1, b1, 3)
#undef GF_LD
#undef GF_USE
    }
    __device__ __forceinline__ void operator()(const f32x4 (&acc)[2][2][4][2], const Unit& u, int wr, int wc, int fr, int fq) const {
        fr = opaque_v(fr); fq = opaque_v(fq);
        const int row0 = u.pm * BM + wr * 64 + fr, col0 = u.pn * BM + wc * 32 + 8 * fq;
        const u32x4* pc = gbase(2, u, wr, wc, fr, fq);
#pragma unroll
        for (int h = 0; h < 1; ++h) {
            u32x4 c[16];
#pragma unroll
            for (int k = 0; k < 16; ++k) c[k] = pc[k * 64];
            asm volatile("" ::: "memory");
#pragma unroll
            for (int k = 0; k < 16; ++k) { const int f = k, ai = f >> 3, m = (f >> 1) & 3, bj = f & 1;
                bf16_t* rowp = O + (size_t)(row0 + ai * HALF + m * 16) * DM + col0; const f32x4 v0 = acc[ai][bj][m][0], v1 = acc[ai][bj][m][1];
                u32x4 w; w.x = cvt_pk_bf16(v0[0] * bf_lo(c[k].x), v0[1] * bf_hi(c[k].x)); w.y = cvt_pk_bf16(v0[2] * bf_lo(c[k].y), v0[3] * bf_hi(c[k].y));
                w.z = cvt_pk_bf16(v1[0] * bf_lo(c[k].z), v1[1] * bf_hi(c[k].z)); w.w = cvt_pk_bf16(v1[2] * bf_lo(c[k].w), v1[3] * bf_hi(c[k].w));
                *(u32x4*)(rowp + bj * HALF) = w; }
        }
    }
};
struct EpiF32 {
    static constexpr bool PERM = true, HAS_MID = false;
    bf16_t* O; int ldc;
    __device__ __forceinline__ void mid(f32x4 (&)[2][2][4][2], const Unit&, int, int, int, int, int) const {}
    __device__ __forceinline__ void operator()(const f32x4 (&acc)[2][2][4][2], const Unit& u, int wr, int wc, int fr, int fq) const {
        fr = opaque_v(fr); fq = opaque_v(fq);
        const int row0 = u.pm * BM + wr * 64 + fr, col0 = u.pn * BM + wc * 32 + 8 * fq;
#pragma unroll
        for (int ai = 0; ai < 2; ++ai)
#pragma unroll
            for (int m = 0; m < 4; ++m) { bf16_t* rowp = O + (size_t)(row0 + ai * HALF + m * 16) * ldc + col0;
#pragma unroll
                for (int bj = 0; bj < 2; ++bj) { const f32x4 v0 = acc[ai][bj][m][0], v1 = acc[ai][bj][m][1];
                    u32x4 w; w.x = cvt_pk_bf16(v0[0], v0[1]); w.y = cvt_pk_bf16(v0[2], v0[3]); w.z = cvt_pk_bf16(v1[0], v1[1]); w.w = cvt_pk_bf16(v1[2], v1[3]);
                    *(u32x4*)(rowp + bj * HALF) = w; } }
    }
};

template <class Epi, class Sched>
__device__ __forceinline__ void gemm_phase(LAS unsigned char* lds, const Gemm g, const Sched& S, const Epi& E, const int tid) {
    const int wid = __builtin_amdgcn_readfirstlane(tid >> 6), lane = tid & 63, wr = wid >> 2, wc = wid & 3, fr = lane & 15, fq = lane >> 4;
    const int K = g.K, nt = K / BK;
    unsigned voffA[2], voffB[2];
#pragma unroll
    for (int i = 0; i < 2; ++i) { int R, C; stage_rc(tid * 16 + i * 8192, R, C); const int Rb = Epi::PERM ? ((R & ~31) + perm32(R & 31)) : R;
        voffA[i] = (unsigned)(R * g.lda + C) * 2u; voffB[i] = (unsigned)(Rb * g.ldb + C) * 2u; }
    const size_t kstep = (size_t)(BK * 2);
    const size_t hstepA = (size_t)HALF * g.lda * 2, hstepB = (size_t)HALF * g.ldb * 2;
    const size_t tstepA = 2 * hstepA, tstepB = 2 * hstepB;
    const unsigned ldsw = (unsigned)wid * 1024u;
    const int aoff = lds_byte(wr * 64 + fr, fq * 8), boff = lds_byte(wc * 32 + fr, fq * 8);
#define PG8_SA(b, h) (((b) * 2 + (h)) * HTB)
#define PG8_SB(b, h) ((4 + (b) * 2 + (h)) * HTB)
#define PG8_STAGE(bufoff, gbase, voff) do { _Pragma("unroll") for (int _i = 0; _i < 2; ++_i) \
        __builtin_amdgcn_global_load_lds((const unsigned*)((const char*)(gbase) + (voff)[_i]), (LAS unsigned*)(lds + (bufoff) + ldsw + _i * 8192), 16, 0, 0); } while (0)
#define PG8_LDA(dst, b, h) do { _Pragma("unroll") for (int m = 0; m < 4; ++m) _Pragma("unroll") for (int k = 0; k < 2; ++k) dst[m][k] = *(const LAS bf16x8*)(lds + PG8_SA(b, h) + aoff + m * 2048 + k * 1024); } while (0)
#define PG8_LDB(dst, b, h) do { _Pragma("unroll") for (int n = 0; n < 2; ++n) _Pragma("unroll") for (int k = 0; k < 2; ++k) dst[n][k] = *(const LAS bf16x8*)(lds + PG8_SB(b, h) + boff + n * 2048 + k * 1024); } while (0)
#define PG8_MMA(ai, bj, At, Bt) do { __builtin_amdgcn_s_setprio(1); _Pragma("unroll") for (int m = 0; m < 4; ++m) _Pragma("unroll") for (int n = 0; n < 2; ++n) _Pragma("unroll") for (int k = 0; k < 2; ++k) \
        acc[ai][bj][m][n] = __builtin_amdgcn_mfma_f32_16x16x32_bf16(Bt[n][k], At[m][k], acc[ai][bj][m][n], 0, 0, 0); __builtin_amdgcn_s_setprio(0); } while (0)
#define PG8_WAIT_V(n) asm volatile("s_waitcnt vmcnt(" #n ")" ::: "memory")
#define PG8_WAIT_L(n) asm volatile("s_waitcnt lgkmcnt(" #n ")" ::: "memory")
#define PG8_BAR __builtin_amdgcn_s_barrier()
#define PG8_SCHED __builtin_amdgcn_sched_barrier(0)
    Unit cur, nxt; int ui = 0;
    if (!S.next(0, cur)) return;
    f32x4 acc[2][2][4][2];
#pragma unroll
    for (int a = 0; a < 2; ++a)
#pragma unroll
        for (int b = 0; b < 2; ++b)
#pragma unroll
            for (int m = 0; m < 4; ++m)
#pragma unroll
                for (int n = 0; n < 2; ++n) acc[a][b][m][n] = (f32x4){0.f, 0.f, 0.f, 0.f};
    bf16x8 At[4][2], B0[2][2], B1[2][2];
    const char* cA = (const char*)g.A + (size_t)cur.pm * tstepA; const char* cB = (const char*)g.Bt + (size_t)cur.pn * tstepB;
    PG8_STAGE(PG8_SB(0, 0), cB, voffB); PG8_STAGE(PG8_SB(0, 1), cB + hstepB, voffB); PG8_STAGE(PG8_SA(0, 0), cA, voffA); PG8_STAGE(PG8_SA(0, 1), cA + hstepA, voffA);
    if (wr == 1) PG8_BAR;
    PG8_WAIT_V(2); PG8_BAR;
    PG8_STAGE(PG8_SB(1, 0), cB + kstep, voffB); PG8_STAGE(PG8_SA(1, 0), cA + kstep, voffA); PG8_STAGE(PG8_SB(1, 1), cB + hstepB + kstep, voffB);
    PG8_WAIT_V(6); PG8_BAR;
    for (;;) {
        const bool has_next = S.next(ui + 1, nxt);
        const char* nA = has_next ? (const char*)g.A + (size_t)nxt.pm * tstepA : cA; const char* nB = has_next ? (const char*)g.Bt + (size_t)nxt.pn * tstepB : cB;
        for (int t = 0; t < nt; t += 2) {
            const bool last = (t == nt - 2);
            const char* a1 = cA + (size_t)(t + 1) * kstep;
            const char* a2 = last ? nA : cA + (size_t)(t + 2) * kstep; const char* b2 = last ? nB : cB + (size_t)(t + 2) * kstep;
            const char* a3 = a2 + kstep; const char* b3 = b2 + kstep;
            if constexpr (Epi::HAS_MID) { if (t == 16 || t == 32) E.mid(acc, cur, t, wr, wc, fr, fq); }
            PG8_LDB(B0, 0, 0); PG8_LDB(B1, 0, 1); PG8_SCHED; PG8_LDA(At, 0, 0); PG8_STAGE(PG8_SA(1, 1), a1 + hstepA, voffA);
            PG8_WAIT_V(8); PG8_WAIT_L(0); PG8_BAR; PG8_MMA(0, 0, At, B0); PG8_MMA(0, 1, At, B1); PG8_BAR; PG8_SCHED;
            PG8_LDA(At, 0, 1); PG8_STAGE(PG8_SB(0, 0), b2, voffB); PG8_STAGE(PG8_SB(0, 1), b2 + hstepB, voffB); PG8_STAGE(PG8_SA(0, 0), a2, voffA);
            PG8_WAIT_V(8); PG8_WAIT_L(0); PG8_BAR; PG8_MMA(1, 0, At, B0); PG8_MMA(1, 1, At, B1); PG8_BAR; PG8_SCHED;
            PG8_LDB(B0, 1, 0); PG8_LDB(B1, 1, 1); PG8_SCHED; PG8_LDA(At, 1, 0); PG8_STAGE(PG8_SA(0, 1), a2 + hstepA, voffA);
            PG8_WAIT_V(8); PG8_WAIT_L(0); PG8_BAR; PG8_MMA(0, 0, At, B0); PG8_MMA(0, 1, At, B1); PG8_BAR; PG8_SCHED;
            PG8_LDA(At, 1, 1); PG8_STAGE(PG8_SB(1, 0), b3, voffB); PG8_STAGE(PG8_SB(1, 1), b3 + hstepB, voffB); PG8_STAGE(PG8_SA(1, 0), a3, voffA);
            PG8_WAIT_V(8); PG8_WAIT_L(0); PG8_BAR; PG8_MMA(1, 0, At, B0); PG8_MMA(1, 1, At, B1); PG8_BAR; PG8_SCHED;
        }
        if (wr == 0) PG8_BAR;
        E(acc, cur, wr, wc, fr, fq);
        if (!has_next) break;
#pragma unroll
        for (int a = 0; a < 2; ++a)
#pragma unroll
            for (int b = 0; b < 2; ++b)
#pragma unroll
                for (int m = 0; m < 4; ++m)
#pragma unroll
                    for (int n = 0; n < 2; ++n) acc[a][b][m][n] = (f32x4){0.f, 0.f, 0.f, 0.f};
        cur = nxt; cA = nA; cB = nB; ++ui;
        if (wr == 1) PG8_BAR;
    }
    PG8_WAIT_V(0);
    PG8_BAR;
#undef PG8_SA
#undef PG8_SB
#undef PG8_STAGE
#undef PG8_LDA
#undef PG8_LDB
#undef PG8_MMA
#undef PG8_WAIT_V
#undef PG8_WAIT_L
#undef PG8_BAR
#undef PG8_SCHED
}
}

namespace att {
constexpr int D = 128, NW = 8, QBLK = 32, KVBLK = 64;
constexpr float SCALE = 0.088388347648318440f, ISCALE = 11.313708498984761f;
constexpr float THR = 8.f, NEG = -30000.f;
constexpr size_t SHM_V = KVBLK * D * 2, SHM_K = KVBLK * D * 2, SHM_WS = 71680  , SHM_TBL = SHM_WS + NW * 64 * 4 + 256, SHM_ATTN = SHM_TBL + 2560;
#define KSWZ(row, colB) ((row) * 256 + ((colB) ^ (((row) & 7) << 4)))
#define SBAR() __builtin_amdgcn_sched_barrier(0)
__device__ __forceinline__ int crow(int r, int hi) { return (r & 3) + 8 * (r >> 2) + 4 * hi; }
__device__ __forceinline__ void partialSM(f32x16& p0, f32x16& p1, float& m_reg, float& mn, float& alpha) {
  constexpr float C = SCALE * 1.4426950408889634f;
  float pmax = p0[0];
#pragma unroll
  for (int r = 1; r < 16; ++r) pmax = fmaxf(pmax, p0[r]);
#pragma unroll
  for (int r = 0; r < 16; ++r) pmax = fmaxf(pmax, p1[r]);
  { auto rr = __builtin_amdgcn_permlane32_swap(__float_as_uint(pmax), __float_as_uint(pmax), false, false);
    pmax = fmaxf(__uint_as_float(rr[0]), __uint_as_float(rr[1])); }
  if (__builtin_expect(__all(pmax - m_reg <= THR / SCALE), 1)) { mn = m_reg; alpha = 1.f; }
  else { mn = fmaxf(m_reg, pmax); alpha = __builtin_amdgcn_exp2f((m_reg - mn) * C); m_reg = mn; }
  float mnC = -mn * C;
#pragma unroll
  for (int r = 0; r < 16; ++r) p0[r] = fmaf(p0[r], C, mnC);
#pragma unroll
  for (int r = 0; r < 16; ++r) p1[r] = fmaf(p1[r], C, mnC);
#pragma unroll
  for (int r = 0; r < 16; ++r) p0[r] = __builtin_amdgcn_exp2f(p0[r]);
}
__device__ __forceinline__ void finishSM(f32x16& p0, f32x16& p1, float alpha, float& l_reg, bf16x8& pa0, bf16x8& pa1, bf16x8& pa2, bf16x8& pa3) {
#pragma unroll
  for (int r = 0; r < 16; ++r) p1[r] = __builtin_amdgcn_exp2f(p1[r]);
  float ps = 0;
#pragma unroll
  for (int r = 0; r < 16; ++r) ps += p0[r];
#pragma unroll
  for (int r = 0; r < 16; ++r) ps += p1[r];
  { auto rr = __builtin_amdgcn_permlane32_swap(__float_as_uint(ps), __float_as_uint(ps), false, false);
    ps = __uint_as_float(rr[0]) + __uint_as_float(rr[1]); }
  l_reg = l_reg * alpha + ps;
#define PK4(P, BASE, OUT) do { unsigned a0 = cvt_pk_bf16(P[BASE + 0], P[BASE + 1]), a1 = cvt_pk_bf16(P[BASE + 2], P[BASE + 3]);   \
    unsigned b0 = cvt_pk_bf16(P[BASE + 4], P[BASE + 5]), b1 = cvt_pk_bf16(P[BASE + 6], P[BASE + 7]);                              \
    auto r0 = __builtin_amdgcn_permlane32_swap(a0, b0, false, false); auto r1 = __builtin_amdgcn_permlane32_swap(a1, b1, false, false); \
    u32x4 w = {r0[0], r1[0], r0[1], r1[1]}; OUT = *reinterpret_cast<bf16x8*>(&w); } while (0)
  PK4(p0, 0, pa0); PK4(p0, 8, pa1); PK4(p1, 0, pa2); PK4(p1, 8, pa3);
#undef PK4
}
__device__ __forceinline__ void qkt(f32x16& p0, f32x16& p1, const char* Ks, const bf16x8* qr, int r32, int hi) {
  p0 = f32x16{}; p1 = f32x16{};
#pragma unroll
  for (int d0 = 0; d0 < 8; ++d0) { int cb = (d0 * 16 + hi * 8) * 2;
    bf16x8 b0 = *reinterpret_cast<const bf16x8*>(Ks + KSWZ(r32, cb));
    bf16x8 b1 = *reinterpret_cast<const bf16x8*>(Ks + KSWZ(32 + r32, cb));
    p0 = __builtin_amdgcn_mfma_f32_32x32x16_bf16(b0, qr[d0], p0, 0, 0, 0);
    p1 = __builtin_amdgcn_mfma_f32_32x32x16_bf16(b1, qr[d0], p1, 0, 0, 0); }
}
__device__ __forceinline__ int v_st(int k, int c) { const int kk = (k & ~0xC) | ((k & 4) << 1) | ((k & 8) >> 1); return ((kk >> 3) * 4 + (c >> 5)) * 512 + ((kk & 7) * 32 + (c & 31)) * 2; }
__device__ __forceinline__ int v_rd_base(int lane) { return ((lane & 3) << 3) | (((lane >> 2) & 3) << 6) | (((lane >> 4) & 1) << 5) | (((lane >> 5) & 1) << 8); }
constexpr int v_rd_off(int d0, int ks, int half) { return d0 * 512 + ks * 4096 + half * 2048; }
template <int OFF> __device__ __forceinline__ s16x4 tr_read(int vb) {
  s16x4 r; asm volatile("ds_read_b64_tr_b16 %0, %1 offset:%2" : "=&v"(r) : "v"(vb), "i"(OFF) : "memory"); return r;
}
template <int D0> __device__ __forceinline__ void pv_one(f32x16& od, int vb, bf16x8 pa0, bf16x8 pa1, bf16x8 pa2, bf16x8 pa3) {
  const s16x4 l0 = tr_read<v_rd_off(D0, 0, 0)>(vb), h0 = tr_read<v_rd_off(D0, 0, 1)>(vb), l1 = tr_read<v_rd_off(D0, 1, 0)>(vb), h1 = tr_read<v_rd_off(D0, 1, 1)>(vb);
  const s16x4 l2 = tr_read<v_rd_off(D0, 2, 0)>(vb), h2 = tr_read<v_rd_off(D0, 2, 1)>(vb), l3 = tr_read<v_rd_off(D0, 3, 0)>(vb), h3 = tr_read<v_rd_off(D0, 3, 1)>(vb);
  asm volatile("s_waitcnt lgkmcnt(0)" ::: "memory"); SBAR();
#define PK(L, H) (bf16x8){L[0], L[1], L[2], L[3], H[0], H[1], H[2], H[3]}
  od = __builtin_amdgcn_mfma_f32_32x32x16_bf16(pa0, PK(l0, h0), od, 0, 0, 0);
  od = __builtin_amdgcn_mfma_f32_32x32x16_bf16(pa1, PK(l1, h1), od, 0, 0, 0);
  od = __builtin_amdgcn_mfma_f32_32x32x16_bf16(pa2, PK(l2, h2), od, 0, 0, 0);
  od = __builtin_amdgcn_mfma_f32_32x32x16_bf16(pa3, PK(l3, h3), od, 0, 0, 0);
#undef PK
}
__device__ __forceinline__ void pv_d0(f32x16* o, int vb, bf16x8 pa0, bf16x8 pa1, bf16x8 pa2, bf16x8 pa3) {
  pv_one<0>(o[0], vb, pa0, pa1, pa2, pa3); pv_one<1>(o[1], vb, pa0, pa1, pa2, pa3); pv_one<2>(o[2], vb, pa0, pa1, pa2, pa3); pv_one<3>(o[3], vb, pa0, pa1, pa2, pa3);
}

struct Unit {
  const bf16_t* Q; const bf16_t* K; const bf16_t* V;
  int ldq, ldk;
  int NT;
  bf16_t* O; int ldo;
  const bf16_t* Z; int ldz;
  float* LSE; int ldl;
  int qr, kr0;
  int i0, k0; float slope;
};

template <int MODE>
__device__ __forceinline__ void amask(f32x16& p0, f32x16& p1, int j, const Unit& U, int wid, int r32, int hi, const float* tbl) {
  if constexpr (MODE == 1) {
    const int qrow = U.qr + (wid >> 1), kr = U.kr0 + j, st = min(max(qrow - 4, 0), 120);
    if (kr < st || kr >= st + 8) {
#pragma unroll
      for (int r = 0; r < 16; ++r) { p0[r] = NEG; p1[r] = NEG; }
    } else {
      const int jq = (wid & 1) * 32 + r32, cs = min(max(jq - 8, 0), 48);
      const float* tr = tbl + (kr - qrow + 7) * 31 + (15 - jq);
#pragma unroll
      for (int r2 = 0; r2 < 8; ++r2) {
        float b0[2], b1[2];
#pragma unroll
        for (int q = 0; q < 2; ++q) { const int c = crow(r2 * 2 + q, hi); b0[q] = tr[c]; b1[q] = tr[c + 32]; }
        asm volatile("" ::: "memory");
#pragma unroll
        for (int q = 0; q < 2; ++q) { const int r = r2 * 2 + q, c = crow(r, hi);
          p0[r] = ((unsigned)(c - cs) < 16u) ? p0[r] + b0[q] : NEG;
          p1[r] = ((unsigned)(c + 32 - cs) < 16u) ? p1[r] + b1[q] : NEG; }
      }
    }
  } else if constexpr (MODE == 2) {
    const int base = U.k0 + j * 64 - (U.i0 + wid * 32 + r32);
#pragma unroll
    for (int r = 0; r < 16; ++r) { const int c = crow(r, hi); const int d0 = abs(base + c), d1 = abs(base + c + 32);
      p0[r] = (d0 <= 64) ? p0[r] - U.slope * (float)d0 : NEG;
      p1[r] = (d1 <= 64) ? p1[r] - U.slope * (float)d1 : NEG; }
  }
}

template <int MODE, int SDEPTH, bool SIMPLE>
__device__ __forceinline__ void attn_body(const Unit& U, char* lds, const int tid) {
  const int wid = tid >> 6, lane = tid & 63, r32 = lane & 31, hi = lane >> 5;
  char* V_lds = lds; char* K_lds = lds + 2 * SHM_V;
  float* ws = (float*)(lds + SHM_WS) + wid * 64; float* li_l = ws; float* al_l = ws + 32;
  const float* tbl = (const float*)(lds + SHM_TBL);
  float m_reg = -1e30f, l_reg = 0; f32x16 o[4] = {}; bf16x8 qr[8];
  const bf16_t* Qw = U.Q + (long)(wid * QBLK + r32) * U.ldq + hi * 8;
#pragma unroll
  for (int d0 = 0; d0 < 8; ++d0) qr[d0] = *reinterpret_cast<const bf16x8*>(Qw + d0 * 16);
  const int sr = tid >> 4, sc = (tid & 15) * 8, vst0 = v_st(sr, sc), vst1 = v_st(32 + sr, sc);
  const int vb0 = (int)(uintptr_t)V_lds + v_rd_base(lane);
  const bf16_t* Kh = U.K; const bf16_t* Vh = U.V; const int LDK = U.ldk;
  struct { bf16x8 vs0, vs1, ks0, ks1; } sr_[SDEPTH];
#define SLOAD(i, k0) do { sr_[i].vs0 = *(const bf16x8*)(&Vh[(long)((k0) + sr) * LDK + sc]); sr_[i].vs1 = *(const bf16x8*)(&Vh[(long)((k0) + 32 + sr) * LDK + sc]); \
    sr_[i].ks0 = *(const bf16x8*)(&Kh[(long)((k0) + sr) * LDK + sc]); sr_[i].ks1 = *(const bf16x8*)(&Kh[(long)((k0) + 32 + sr) * LDK + sc]); } while (0)
#define SWRITE(b, i) do { *(bf16x8*)(V_lds + (b) * SHM_V + vst0) = sr_[i].vs0;          \
    *(bf16x8*)(V_lds + (b) * SHM_V + vst1) = sr_[i].vs1; int kc = sc * 2;               \
    *(bf16x8*)(K_lds + (b) * SHM_K + KSWZ(sr, kc)) = sr_[i].ks0;                       \
    *(bf16x8*)(K_lds + (b) * SHM_K + KSWZ(32 + sr, kc)) = sr_[i].ks1; } while (0)
#define SWAIT() do { if constexpr (SDEPTH == 2) asm volatile("s_waitcnt vmcnt(4)" ::: "memory"); else asm volatile("s_waitcnt vmcnt(0)" ::: "memory"); } while (0)
#define RESC(a) do { if (__any((a) < 1.f)) { if (hi == 0) al_l[r32] = (a); asm volatile("s_waitcnt lgkmcnt(0)" ::: "memory"); \
    _Pragma("unroll") for (int d = 0; d < 4; ++d) _Pragma("unroll") for (int r = 0; r < 16; ++r) o[d][r] *= al_l[crow(r, hi)]; } } while (0)
  bf16x8 pa0, pa1, pa2, pa3; const int NT = U.NT;
  if constexpr (SIMPLE) {
    f32x16 p0, p1; float mn, al;
    SLOAD(0, 0);
    for (int j = 0; j < NT; ++j) {
      asm volatile("s_waitcnt vmcnt(0)" ::: "memory"); __syncthreads(); SWRITE(0, 0);
      if (j + 1 < NT) SLOAD(0, (j + 1) * KVBLK);
      __syncthreads();
      bool act = true;
      if constexpr (MODE == 1) { const int qrow = U.qr + (wid >> 1), kr = U.kr0 + j, st = min(max(qrow - 4, 0), 120); act = (kr >= st) && (kr < st + 8); }
      if constexpr (MODE == 2) { const int q0 = U.i0 + wid * 32, t0 = U.k0 + j * 64; act = (t0 + 63 >= q0 - 64) && (t0 <= q0 + 31 + 64); }
      if (act) {
        qkt(p0, p1, K_lds, qr, r32, hi); amask<MODE>(p0, p1, j, U, wid, r32, hi, tbl);
        partialSM(p0, p1, m_reg, mn, al); finishSM(p0, p1, al, l_reg, pa0, pa1, pa2, pa3);
        RESC(al); SBAR();
        pv_d0(o, vb0, pa0, pa1, pa2, pa3);
      }
    }
  } else {
  f32x16 pA0, pA1, pB0, pB1; float mnA, mnB, alA, alB;
  constexpr int SE = 0, SO = SDEPTH - 1;
  SLOAD(SE, 0); if constexpr (SDEPTH == 2) SLOAD(SO, KVBLK);
  asm volatile("s_waitcnt vmcnt(0)" ::: "memory"); SWRITE(0, SE); __syncthreads();
  qkt(pA0, pA1, K_lds, qr, r32, hi); amask<MODE>(pA0, pA1, 0, U, wid, r32, hi, tbl); partialSM(pA0, pA1, m_reg, mnA, alA);
  if constexpr (SDEPTH != 2) SLOAD(SO, KVBLK);
  if constexpr (SDEPTH == 2) { if (2 < NT) SLOAD(SE, 2 * KVBLK); }
  SWAIT(); SWRITE(1, SO); __syncthreads();
  for (int j = 1; j + 1 < NT; j += 2) {
    SBAR(); qkt(pB0, pB1, K_lds + SHM_K, qr, r32, hi); amask<MODE>(pB0, pB1, j, U, wid, r32, hi, tbl);
    finishSM(pA0, pA1, alA, l_reg, pa0, pa1, pa2, pa3); SBAR();
    SLOAD(SO, (j + SDEPTH) * KVBLK); SBAR();
    pv_d0(o, vb0, pa0, pa1, pa2, pa3); partialSM(pB0, pB1, m_reg, mnB, alB);
    __syncthreads(); SWAIT(); SWRITE(0, SE);
    RESC(alB); __syncthreads();
    SBAR(); qkt(pA0, pA1, K_lds, qr, r32, hi); amask<MODE>(pA0, pA1, j + 1, U, wid, r32, hi, tbl);
    finishSM(pB0, pB1, alB, l_reg, pa0, pa1, pa2, pa3); SBAR();
    if (SDEPTH == 1 || j + 3 < NT) SLOAD(SE, (j + 1 + SDEPTH) * KVBLK); SBAR();
    pv_d0(o, vb0 + (int)SHM_V, pa0, pa1, pa2, pa3); partialSM(pA0, pA1, m_reg, mnA, alA);
    __syncthreads(); SWAIT(); SWRITE(1, SO);
    RESC(alA); __syncthreads();
  }
  SBAR(); qkt(pB0, pB1, K_lds + SHM_K, qr, r32, hi); amask<MODE>(pB0, pB1, NT - 1, U, wid, r32, hi, tbl);
  finishSM(pA0, pA1, alA, l_reg, pa0, pa1, pa2, pa3); SBAR();
  pv_d0(o, vb0, pa0, pa1, pa2, pa3); partialSM(pB0, pB1, m_reg, mnB, alB);
  __syncthreads(); RESC(alB);
  finishSM(pB0, pB1, alB, l_reg, pa0, pa1, pa2, pa3); SBAR();
  pv_d0(o, vb0 + (int)SHM_V, pa0, pa1, pa2, pa3);
  }
  if (hi == 0) li_l[r32] = l_reg; asm volatile("s_waitcnt lgkmcnt(0)" ::: "memory");
  if constexpr (MODE == 2) { if (hi == 0) U.LSE[(long)(wid * QBLK + r32) * U.ldl] = m_reg * SCALE + __logf(l_reg); }
  __syncthreads();
  constexpr int OP = 136;
  bf16_t* ol = (bf16_t*)lds + wid * (32 * OP);
#pragma unroll
  for (int r = 0; r < 16; ++r) { const float rl = __builtin_amdgcn_rcpf(li_l[crow(r, hi)]); bf16_t* op = ol + crow(r, hi) * OP + r32;
#pragma unroll
    for (int d0 = 0; d0 < 4; ++d0) op[d0 * 32] = (bf16_t)(cvt_pk_bf16(o[d0][r] * rl, 0.f) & 0xffffu); }
  asm volatile("s_waitcnt lgkmcnt(0)" ::: "memory");
  { const int cc = (lane & 15) * 8, rb = lane >> 4;
    u32x4 zz[8];
    if constexpr (MODE != 2) {
#pragma unroll
      for (int i = 0; i < 8; ++i) zz[i] = *(const u32x4*)(U.Z + (long)(wid * QBLK + rb + 4 * i) * U.ldz + cc);
    }
#pragma unroll
    for (int i = 0; i < 8; ++i) { const int row = rb + 4 * i; const long orow = wid * QBLK + row;
      u32x4 v = *(const u32x4*)(ol + row * OP + cc);
      if constexpr (MODE != 2) { const u32x4 z = zz[i];
#pragma unroll
        for (int q = 0; q < 4; ++q) v[q] = cvt_pk_bf16(bf_lo(v[q]) * bf_lo(z[q]), bf_hi(v[q]) * bf_hi(z[q])); }
      *(u32x4*)(U.O + orow * U.ldo + cc) = v; } }
#undef SLOAD
#undef SWRITE
#undef SWAIT
#undef RESC
}
}

#define XB_TMO      128
#define XB_XCNT(j)  (256  + 64 * (j))
#define XB_XSUB(j)  (1280 + 64 * (j))
#define XB_XGEN(j)  (2304 + 64 * (j))
#define XB_TOP      3328
#define XB_TOPGEN   3392
#define XCD_BAR_WORDS 3456
#define XB_SPIN_CAP (1u << 18)

__device__ __forceinline__ unsigned xb_ld(unsigned* p)              { return __hip_atomic_load(p, __ATOMIC_RELAXED, __HIP_MEMORY_SCOPE_AGENT); }
__device__ __forceinline__ unsigned xb_add(unsigned* p, unsigned v) { return __hip_atomic_fetch_add(p, v, __ATOMIC_RELAXED, __HIP_MEMORY_SCOPE_AGENT); }
__device__ __forceinline__ unsigned xb_xcc_id() { return (unsigned)__builtin_amdgcn_s_getreg((3 << 11) | 20) & 0xFu; }
#define XB_SPIN(cond, bar) do { unsigned _sp = 0; while (cond) { __builtin_amdgcn_s_sleep(1); \
    if ((++_sp & 255u) == 0u) { if (xb_ld(&(bar)[XB_TMO])) break; if (_sp > XB_SPIN_CAP) { atomicAdd(&(bar)[XB_TMO], 1u); break; } } } } while (0)

struct XcdBarrier {
    unsigned* bar; unsigned x;
    volatile LAS unsigned* st;
};

__device__ __forceinline__ XcdBarrier xcd_barrier_post(unsigned* bar, volatile LAS unsigned* st) {
    XcdBarrier b; b.bar = bar; b.x = xb_xcc_id(); b.st = st;
    if (threadIdx.x == 0) (void)xb_add(&bar[XB_XCNT(b.x)], 1u);
    return b;
}
__device__ __forceinline__ void xcd_barrier_complete(unsigned* bar, unsigned x, unsigned& nloc, unsigned& nx) {
    const unsigned G = gridDim.x * gridDim.y * gridDim.z;
    unsigned sum, cnt, mine, sp = 0u;
    for (;;) {
        sum = 0u; cnt = 0u; mine = 0u;
#pragma unroll
        for (unsigned j = 0; j < 16; ++j) { const unsigned c = xb_ld(&bar[XB_XCNT(j)]); sum += c; cnt += (c > 0u) ? 1u : 0u; mine = (j == x) ? c : mine; }
        if (sum == G) break;
        __builtin_amdgcn_s_sleep(1);
        if ((++sp & 255u) == 0u) { if (xb_ld(&bar[XB_TMO])) break; if (sp > XB_SPIN_CAP) { atomicAdd(&bar[XB_TMO], 1u); break; } }
    }
    nloc = mine > 0u ? mine : 1u; nx = cnt > 0u ? cnt : 1u;
}

__device__ __forceinline__ void xcd_barrier(const XcdBarrier& b) {
    asm volatile("s_waitcnt vmcnt(0)" ::: "memory");
    __syncthreads();
    if (threadIdx.x == 0) {
        unsigned* bar = b.bar;
        __builtin_amdgcn_s_waitcnt(0);
        unsigned nloc = b.st[0], nx = b.st[1];
        if (nloc == 0u) { xcd_barrier_complete(bar, b.x, nloc, nx); b.st[0] = nloc; b.st[1] = nx; }
        const unsigned old = xb_add(&bar[XB_XSUB(b.x)], 1u);
        const unsigned gen = old / nloc;
        if (old + 1u == (gen + 1u) * nloc) {
            __builtin_amdgcn_fence(__ATOMIC_RELEASE, "agent");
            asm volatile("s_waitcnt vmcnt(0)" ::: "memory");
            const unsigned og = xb_add(&bar[XB_TOP], 1u);
            const unsigned tg = og / nx;
            if (og + 1u == (tg + 1u) * nx) xb_add(&bar[XB_TOPGEN], 1u);
            else XB_SPIN(xb_ld(&bar[XB_TOPGEN]) == tg, bar);
            __builtin_amdgcn_fence(__ATOMIC_ACQUIRE, "agent");
            xb_add(&bar[XB_XGEN(b.x)], 1u);
            asm volatile("s_waitcnt vmcnt(0)" ::: "memory");
        } else {
            XB_SPIN(xb_ld(&bar[XB_XGEN(b.x)]) == gen, bar);
            __builtin_amdgcn_fence(__ATOMIC_ACQUIRE, "agent");
            asm volatile("s_waitcnt vmcnt(0)" ::: "memory");
        }
    }
    __syncthreads();
}


constexpr int LDS_BYTES = 128 * 1024 + 256;
static_assert(att::SHM_ATTN <= 128 * 1024 && pg8::STAGE_BYTES <= 128 * 1024 && XCD_BAR_WORDS * 4 <= 16384, "LDS");
struct Args { const float* in[12]; float* out; unsigned char* ws; int ph_lo, ph_hi; };
constexpr int NPHASE = 1 + 6 * DEPTH;

__device__ __forceinline__ float wave_sum(float v) {
#pragma unroll
  for (int o = 1; o < 64; o <<= 1) v += __shfl_xor(v, o);
  return v;
}
struct TrItem { const float* W; bf16_t* WT; int N, ldt, koff, item; };
__device__ __forceinline__ void tr_load(const TrItem& t, int lane, float (&v)[32]) {
  const int nblk = t.N / 32, kb = t.item / nblk, nb = t.item % nblk, k0 = 64 * kb, n0 = 32 * nb;
  const float* p = t.W + (size_t)(k0 + (lane >> 5)) * t.N + n0 + (lane & 31);
#pragma unroll
  for (int i = 0; i < 32; ++i) v[i] = p[(size_t)(2 * i) * t.N];
}
__device__ __forceinline__ void tr_finish(const TrItem& t, int lane, const float (&v)[32], LAS float* scr) {
  const int nblk = t.N / 32, kb = t.item / nblk, nb = t.item % nblk, k0 = 64 * kb, n0 = 32 * nb;
#pragma unroll
  for (int i = 0; i < 32; ++i) scr[(2 * i + (lane >> 5)) * 33 + (lane & 31)] = v[i];
  asm volatile("s_waitcnt lgkmcnt(0)" ::: "memory");
  const int c = lane & 7;
#pragma unroll
  for (int j = 0; j < 4; ++j) { const int n = (lane >> 3) + 8 * j; const LAS float* sp = scr + (8 * c) * 33 + n;
    u32x4 o; o.x = cvt_pk_bf16(sp[0 * 33], sp[1 * 33]); o.y = cvt_pk_bf16(sp[2 * 33], sp[3 * 33]); o.z = cvt_pk_bf16(sp[4 * 33], sp[5 * 33]); o.w = cvt_pk_bf16(sp[6 * 33], sp[7 * 33]);
    *(u32x4*)(t.WT + (size_t)(n0 + n) * t.ldt + t.koff + k0 + 8 * c) = o; }
  asm volatile("s_waitcnt lgkmcnt(0)" ::: "memory");
}

constexpr int I_IN = (DM / 64) * (NIN / 32), I_A = (1024 / 64) * (DM / 32), I_C = (512 / 64) * (DM / 32), I_O = (DM / 64) * (DM / 32);
constexpr int I_L = I_IN + 2 * I_A + I_C + I_O;
#define PH_LOCALS \
  const int tid = opaque_v(wave_s * 64 + (int)__builtin_amdgcn_mbcnt_hi(~0u, __builtin_amdgcn_mbcnt_lo(~0u, 0u))), wave = tid >> 6, lane = tid & 63; \
  const int G = opaque_si((int)gridDim.x), cu = opaque_si((int)blockIdx.x); \
  const int gw = cu * 8 + wave, NGW = G * 8; \
  unsigned char* ws = a.ws + (size_t)(unsigned)opaque_si(0);     \
  bf16_t* WinT = (bf16_t*)(ws + WS_WIN); bf16_t* WbrT = (bf16_t*)(ws + WS_WBR); bf16_t* WoutT = (bf16_t*)(ws + WS_WOUT); \
  bf16_t* H = (bf16_t*)(ws + WS_H); bf16_t* PROJ = (bf16_t*)(ws + WS_PROJ); bf16_t* Y = (bf16_t*)(ws + WS_Y); \
  bf16_t* QBc = (bf16_t*)(ws + WS_QB); bf16_t* KBc = (bf16_t*)(ws + WS_KB); bf16_t* VBc = (bf16_t*)(ws + WS_VB); \
  bf16_t* OC = (bf16_t*)(ws + WS_OC); float* LSE = (float*)(ws + WS_LSE); bf16_t* MRG = (bf16_t*)(ws + WS_MRG); float* OUTF = (float*)(ws + WS_OUT); \
  const float* x_in = a.in[0]; const float* pre_g = a.in[1]; const float* w_in = a.in[2]; const float* b_gate = a.in[3]; \
  const float* qn_g = a.in[4]; const float* kn_g = a.in[5]; const float* rpb = a.in[6]; \
  const float* w_a = a.in[7]; const float* w_b = a.in[8]; const float* w_c = a.in[9]; const float* w_out = a.in[10]; const float* post_g = a.in[11]; \
  float* X = a.out;
__global__ void __launch_bounds__(512) mega(Args a) {
  extern __shared__ __attribute__((aligned(16))) char shm[];
  LAS unsigned char* lds = (LAS unsigned char*)shm;
  cg::grid_group grid = cg::this_grid();
  volatile LAS unsigned* xst = (volatile LAS unsigned*)(lds + 128 * 1024);
  if (threadIdx.x == 0) { xst[0] = 0u; xst[1] = 0u; xst[2] = 0u; xst[3] = 0u; }
  __syncthreads();
  const XcdBarrier xb = xcd_barrier_post((unsigned*)(a.ws + WS_BAR), xst);
  if (a.ph_hi - a.ph_lo > 1) grid.sync();
  const int wave_s = __builtin_amdgcn_readfirstlane((int)threadIdx.x >> 6);

  if ((PHMASK & 1) && a.ph_lo == 0) {
      PH_LOCALS
      LAS float* scr = (LAS float*)(lds + wave * 16384);
      { f32x4 gg[8];
#pragma unroll
        for (int j = 0; j < 8; ++j) gg[j] = ((const f32x4*)pre_g)[64 * j + lane];
        for (int m0 = gw; m0 < MT; m0 += 2 * NGW) {
          f32x4 v[2][8];
#pragma unroll
          for (int h = 0; h < 2; ++h) { const int m = m0 + h * NGW; const f32x4* xr = (const f32x4*)(x_in + (size_t)(m < MT ? m : m0) * DM) + lane;
#pragma unroll
            for (int j = 0; j < 8; ++j) v[h][j] = xr[64 * j]; }
#pragma unroll
          for (int h = 0; h < 2; ++h) { const int m = m0 + h * NGW; if (m < MT) {
            f32x4* xo = (f32x4*)(X + (size_t)m * DM) + lane; float s = 0.f;
#pragma unroll
            for (int j = 0; j < 8; ++j) { xo[64 * j] = v[h][j]; s += (v[h][j].x * v[h][j].x + v[h][j].y * v[h][j].y) + (v[h][j].z * v[h][j].z + v[h][j].w * v[h][j].w); }
            const float r = rsqrtf(wave_sum(s) * (1.f / DM) + EPS);
            u32x2* ho = (u32x2*)(H + (size_t)m * DM) + lane;
#pragma unroll
            for (int j = 0; j < 8; ++j) { const f32x4 g = gg[j]; u32x2 w; w.x = cvt_pk_bf16(v[h][j].x * r * g.x, v[h][j].y * r * g.y); w.y = cvt_pk_bf16(v[h][j].z * r * g.z, v[h][j].w * r * g.w); ho[64 * j] = w; }
          } }
        }
      }
  }
  for (int ph = a.ph_lo; ph < a.ph_hi; ++ph) {
    if (ph > a.ph_lo) xcd_barrier(xb);
    {
      const int sub0 = ph > 0 ? (ph - 1) % 6 : -1, lyr = ph > 0 ? (ph - 1) / 6 + 1 : 0;
      const int Gs = opaque_si((int)gridDim.x), cus = opaque_si((int)blockIdx.x);
      const int nwg_in = (MT / 256) * (NIN / 256), rem = nwg_in % Gs;
      const bool all = (ph == 0), part = (sub0 == 0 && lyr < DEPTH && rem > 0 && cus >= rem);
      if ((PHMASK & 1) && (all || part)) {
        PH_LOCALS
        LAS float* scr = (LAS float*)(lds + wave * 16384);
        const int gwi = all ? gw : (cu - rem) * 8 + wave, nwi = all ? NGW : (G - rem) * 8;
#define TR_DEC(IT, T) TrItem T; { const int l_ = lyr; int r_ = (IT) - lyr * I_L; \
          if (r_ < I_IN) { T.W = w_in + (size_t)l_ * DM * NIN; T.WT = WinT + (size_t)l_ * NIN * DM; T.N = NIN; T.ldt = DM; T.koff = 0; } \
          else if ((r_ -= I_IN) < I_A) { T.W = w_a + (size_t)l_ * 1024 * DM; T.WT = WbrT + (size_t)l_ * DM * YW; T.N = DM; T.ldt = YW; T.koff = 0; } \
          else if ((r_ -= I_A) < I_A) { T.W = w_b + (size_t)l_ * 1024 * DM; T.WT = WbrT + (size_t)l_ * DM * YW; T.N = DM; T.ldt = YW; T.koff = 1024; } \
          else if ((r_ -= I_A) < I_C) { T.W = w_c + (size_t)l_ * 512 * DM; T.WT = WbrT + (size_t)l_ * DM * YW; T.N = DM; T.ldt = YW; T.koff = 2048; } \
          else { r_ -= I_C; T.W = w_out + (size_t)l_ * DM * DM; T.WT = WoutT + (size_t)l_ * DM * DM; T.N = DM; T.ldt = DM; T.koff = 0; } \
          T.item = r_; }
        const int it_end = (lyr + 1) * I_L;
        for (int it = lyr * I_L + gwi; it < it_end; it += 2 * nwi) {
          const bool h1 = it + nwi < it_end;
          float v0[32], v1[32];
          TR_DEC(it, T0) TR_DEC(h1 ? it + nwi : it, T1)
          tr_load(T0, lane, v0); tr_load(T1, lane, v1);
          tr_finish(T0, lane, v0, scr);
          if (h1) tr_finish(T1, lane, v1, scr);
        }
#undef TR_DEC
        __syncthreads();
      }
    }
    const int nrep = (PROBE_SUB == 6 ? ph == 0 : (ph > 0 && (ph - 1) % 6 == PROBE_SUB)) ? 2 : 1;
    for (int rep = 0; rep < nrep; ++rep) {
    if (rep) xcd_barrier(xb);
    if (ph == 0) {
    } else {
    const int l = (ph - 1) / 6, sub = (ph - 1) % 6;
    if ((PHMASK & 2) && sub == 0) {
      PH_LOCALS
      pg8::Gemm g{H, WinT + (size_t)l * NIN * DM, MT, NIN, DM, DM, DM};
      pg8::StaticOrder S; S.init(MT, NIN, G, cu);
      pg8::EpiProj E{PROJ, b_gate + (size_t)l * 3 * DM, (u32x4*)(ws + WS_GF)};
      pg8::gemm_phase<pg8::EpiProj, pg8::StaticOrder>(lds, g, S, E, tid);
    } else if ((PHMASK & 4) && sub == 1) {
      PH_LOCALS
      if (P2MASK & 1) {
        const int sb = lane >> 4, u = lane & 15;
        auto prep_item = [&](const int it, const u32x4 raw) {
          const int tok = it / 3, quad = it % 3, hh = quad * 4 + sb, b = tok >> 13, s = tok & (SEQ - 1);
          float xv[8];
#pragma unroll
          for (int q = 0; q < 4; ++q) { xv[2 * q] = bf_lo(raw[q]); xv[2 * q + 1] = bf_hi(raw[q]); }
          u32x4 ov = raw;
          if (hh < 10) {
            float ss = 0.f;
#pragma unroll
            for (int j = 0; j < 8; ++j) ss += xv[j] * xv[j];
            ss += __shfl_xor(ss, 1); ss += __shfl_xor(ss, 2); ss += __shfl_xor(ss, 4); ss += __shfl_xor(ss, 8);
            const float rn = rsqrtf(ss * (1.f / 128.f) + EPS);
            const float* gp = (hh < 8 ? qn_g : kn_g) + l * 128 + u * 8;
            const float pos = (float)((u < 8) ? (s >> 6) : (s & 63));
            const bool upper = (u & 4) != 0;
            float yv[8];
#pragma unroll
            for (int j = 0; j < 8; ++j) {
              const float y = xv[j] * rn * gp[j];
              const float p = __shfl_xor(y, 4);
              const int fi = (u & 3) * 8 + j;
              const float rev = pos * __builtin_amdgcn_exp2f(-0.41524101186092029f * (float)fi) * 0.15915494309189535f;
              const float cs = __builtin_amdgcn_cosf(rev), sn = __builtin_amdgcn_sinf(rev);
              yv[j] = upper ? (p * sn + y * cs) : (y * cs - p * sn);
            }
#pragma unroll
            for (int q = 0; q < 4; ++q) ov[q] = cvt_pk_bf16(yv[2 * q], yv[2 * q + 1]);
          }
          bf16_t* dst = hh < 8 ? QBc + ((size_t)(b * 8 + hh) * SEQ + s) * 128 : (hh < 10 ? KBc + ((size_t)(b * 2 + hh - 8) * SEQ + s) * 128 : VBc + ((size_t)(b * 2 + hh - 10) * SEQ + s) * 128);
          *(u32x4*)(dst + u * 8) = ov;
        };
        auto prep_src = [&](const int it) { const int tok = it / 3, hh = (it % 3) * 4 + sb; return (const u32x4*)(PROJ + (size_t)tok * NIN + C_QB + hh * 128 + u * 8); };
        int it0 = gw;
        for (; it0 + 3 * NGW < MT * 3; it0 += 4 * NGW) {
          const u32x4 r0 = *prep_src(it0), r1 = *prep_src(it0 + NGW), r2 = *prep_src(it0 + 2 * NGW), r3 = *prep_src(it0 + 3 * NGW);
          prep_item(it0, r0); prep_item(it0 + NGW, r1); prep_item(it0 + 2 * NGW, r2); prep_item(it0 + 3 * NGW, r3);
        }
        for (; it0 < MT * 3; it0 += NGW) prep_item(it0, *prep_src(it0));
      }
      if (P2MASK & 2) for (int un = cu; un < NB * 8 * 32; un += G) {
        const int qb = un & 31, h = (un >> 5) & 7, b = un >> 8;
        const int r0 = qb * 4, kr0 = min(max(r0 - 4, 0), 120), krl = min(max(r0 + 3 - 4, 0), 120) + 7;
        __syncthreads();
        if (tid < 465) ((float*)(shm + att::SHM_TBL))[tid] = rpb[(size_t)(l * 8 + h) * 465 + tid] * att::ISCALE;
        att::Unit U{};
        const size_t tq = (size_t)b * SEQ + r0 * 64, tk = (size_t)b * SEQ + kr0 * 64;
        U.Q = PROJ + tq * NIN + C_QA + h * 128; U.K = PROJ + tk * NIN + C_KA + h * 128; U.V = PROJ + tk * NIN + C_VA + h * 128;
        U.ldq = NIN; U.ldk = NIN; U.NT = krl - kr0 + 1;
        U.O = Y + tq * YW + h * 128; U.ldo = YW; U.Z = PROJ + tq * NIN + C_ZA + h * 128; U.ldz = NIN;
        U.qr = r0; U.kr0 = kr0;
        att::attn_body<1, NA_SD, NA_SIMPLE>(U, shm, opaque_v(tid));
      }
      if (P2MASK & 4) for (int un = cu; un < 3 * NB * 4 * 32; un += G) {
        const int qbi = un & 31, hg = (un >> 5) & 3, b = (un >> 7) & 1, g = un >> 8;
        const int dil = g == 0 ? 1 : (g == 1 ? 4 : 16), L = SEQ / dil, npc = L / 256, c = qbi / npc, i0 = (qbi % npc) * 256;
        const int k0 = max(i0 - 64, 0), kend = min(i0 + 320, L), head = g * 4 + hg;
        __syncthreads();
        att::Unit U{};
        const size_t tq = (size_t)b * SEQ + (size_t)i0 * dil + c, tk = (size_t)b * SEQ + (size_t)k0 * dil + c;
        U.Q = PROJ + tq * NIN + C_QC + head * 128; U.K = PROJ + tk * NIN + C_KC + head * 128; U.V = PROJ + tk * NIN + C_VC + head * 128;
        U.ldq = NIN * dil; U.ldk = NIN * dil; U.NT = (kend - k0) >> 6;
        U.O = OC + ((size_t)g * MT + tq) * 512 + hg * 128; U.ldo = 512 * dil;
        U.LSE = LSE + ((size_t)g * MT + tq) * 4 + hg; U.ldl = 4 * dil;
        U.i0 = i0; U.k0 = k0; U.slope = exp2f(-8.f * (float)(head + 1) / 12.f) * (float)dil * att::ISCALE;
        att::attn_body<2, DIL_SD, DIL_SIMPLE>(U, shm, opaque_v(tid));
      }
    } else if ((PHMASK & 8) && sub == 2) {
      PH_LOCALS
      {
        const int hg = lane >> 4, e8 = (lane & 15) * 8;
        struct MixIn { float l0, l1, l2; u32x4 o0, o1, o2, z; };
        auto mix_load = [&](const int tok) { MixIn m;
          m.l0 = LSE[((size_t)0 * MT + tok) * 4 + hg]; m.l1 = LSE[((size_t)1 * MT + tok) * 4 + hg]; m.l2 = LSE[((size_t)2 * MT + tok) * 4 + hg];
          m.o0 = *(const u32x4*)(OC + ((size_t)0 * MT + tok) * 512 + hg * 128 + e8); m.o1 = *(const u32x4*)(OC + ((size_t)1 * MT + tok) * 512 + hg * 128 + e8);
          m.o2 = *(const u32x4*)(OC + ((size_t)2 * MT + tok) * 512 + hg * 128 + e8); m.z = *(const u32x4*)(PROJ + (size_t)tok * NIN + C_ZC + hg * 128 + e8); return m; };
        auto mix_item = [&](const int tok, const MixIn& m) {
          const float mx = fmaxf(m.l0, fmaxf(m.l1, m.l2)), e0 = __expf(m.l0 - mx), e1 = __expf(m.l1 - mx), e2 = __expf(m.l2 - mx), inv = 1.f / (e0 + e1 + e2);
          const float w0 = e0 * inv, w1 = e1 * inv, w2 = e2 * inv;
          u32x4 w;
#pragma unroll
          for (int q = 0; q < 4; ++q) { const float lo = (w0 * bf_lo(m.o0[q]) + w1 * bf_lo(m.o1[q]) + w2 * bf_lo(m.o2[q])) * bf_lo(m.z[q]), hi_ = (w0 * bf_hi(m.o0[q]) + w1 * bf_hi(m.o1[q]) + w2 * bf_hi(m.o2[q])) * bf_hi(m.z[q]); w[q] = cvt_pk_bf16(lo, hi_); }
          *(u32x4*)(Y + (size_t)tok * YW + 2048 + hg * 128 + e8) = w; };
        int tok0 = gw;
        for (; tok0 + 3 * NGW < MT; tok0 += 4 * NGW) {
          const MixIn m0 = mix_load(tok0), m1 = mix_load(tok0 + NGW), m2 = mix_load(tok0 + 2 * NGW), m3 = mix_load(tok0 + 3 * NGW);
          mix_item(tok0, m0); mix_item(tok0 + NGW, m1); mix_item(tok0 + 2 * NGW, m2); mix_item(tok0 + 3 * NGW, m3);
        }
        for (; tok0 < MT; tok0 += NGW) mix_item(tok0, mix_load(tok0));
      }
      for (int i = 0;; ++i) {
        const int un = i * G + cu; if (un >= NB * 8 * 32) break;
        const int h = un & 7, qb = (un >> 3) & 31, b = un >> 8;
        __syncthreads();
        att::Unit U{};
        const size_t tq = (size_t)b * SEQ + qb * 256;
        U.Q = QBc + ((size_t)(b * 8 + h) * SEQ + qb * 256) * 128; U.K = KBc + (size_t)(b * 2 + (h >> 2)) * SEQ * 128; U.V = VBc + (size_t)(b * 2 + (h >> 2)) * SEQ * 128;
        U.ldq = 128; U.ldk = 128; U.NT = SEQ / 64;
        U.O = Y + tq * YW + 1024 + h * 128; U.ldo = YW; U.Z = PROJ + tq * NIN + C_ZB + h * 128; U.ldz = NIN;
        att::attn_body<0, 2, false>(U, shm, opaque_v(tid));
      }
    } else if ((PHMASK & 16) && sub == 3) {
      PH_LOCALS
      pg8::Gemm g{Y, WbrT + (size_t)l * DM * YW, MT, DM, YW, YW, YW};
      pg8::StaticOrder S; S.init(MT, DM, G, cu);
      pg8::EpiMerged E{(const u32x4*)(ws + WS_GF), MRG};
      pg8::gemm_phase<pg8::EpiMerged, pg8::StaticOrder>(lds, g, S, E, tid);
    } else if ((PHMASK & 32) && sub == 4) {
      PH_LOCALS
      pg8::Gemm g{MRG, WoutT + (size_t)l * DM * DM, MT, DM, DM, DM, DM};
      pg8::StaticOrder S; S.init(MT, DM, G, cu);
      pg8::EpiF32 E{(bf16_t*)OUTF, DM};
      pg8::gemm_phase<pg8::EpiF32, pg8::StaticOrder>(lds, g, S, E, tid);
    } else if (PHMASK & 64) {
      PH_LOCALS
      f32x4 gpost[8], gpre[8];
#pragma unroll
      for (int j = 0; j < 8; ++j) { const int e4 = 128 * (j >> 1) + 2 * lane + (j & 1);
        gpost[j] = ((const f32x4*)(post_g + (size_t)l * DM))[e4];
        gpre[j] = ((const f32x4*)(pre_g + (size_t)(l + 1 < DEPTH ? l + 1 : l) * DM))[e4]; }
      for (int m0 = gw; m0 < MT; m0 += 2 * NGW) {
        f32x4 v[2][8], xv[2][8];
#pragma unroll
        for (int h = 0; h < 2; ++h) { const size_t m = (size_t)m0 + (size_t)h * NGW; const u32x4* orow = (const u32x4*)((const bf16_t*)OUTF + m * DM) + lane; const f32x4* xi = (const f32x4*)(X + m * DM) + 2 * lane;
#pragma unroll
          for (int jj = 0; jj < 4; ++jj) { const u32x4 w = orow[64 * jj];
            v[h][2 * jj] = (f32x4){bf_lo(w.x), bf_hi(w.x), bf_lo(w.y), bf_hi(w.y)}; v[h][2 * jj + 1] = (f32x4){bf_lo(w.z), bf_hi(w.z), bf_lo(w.w), bf_hi(w.w)};
            xv[h][2 * jj] = xi[128 * jj]; xv[h][2 * jj + 1] = xi[128 * jj + 1]; } }
#pragma unroll
        for (int h = 0; h < 2; ++h) { const size_t m = (size_t)m0 + (size_t)h * NGW; f32x4* xo = (f32x4*)(X + m * DM) + 2 * lane;
          float s = 0.f;
#pragma unroll
          for (int j = 0; j < 8; ++j) s += (v[h][j].x * v[h][j].x + v[h][j].y * v[h][j].y) + (v[h][j].z * v[h][j].z + v[h][j].w * v[h][j].w);
          const float r = rsqrtf(wave_sum(s) * (1.f / DM) + EPS);
          float s2 = 0.f;
#pragma unroll
          for (int j = 0; j < 8; ++j) { const int e4 = 128 * (j >> 1) + 2 * lane + (j & 1);
            const f32x4 g = gpost[j]; (void)e4;
            v[h][j] = xv[h][j] + v[h][j] * r * g; xo[128 * (j >> 1) + (j & 1)] = v[h][j]; s2 += (v[h][j].x * v[h][j].x + v[h][j].y * v[h][j].y) + (v[h][j].z * v[h][j].z + v[h][j].w * v[h][j].w); }
          if (l + 1 < DEPTH) {
            const float r2 = rsqrtf(wave_sum(s2) * (1.f / DM) + EPS);
            u32x4* ho = (u32x4*)(H + m * DM) + lane;
#pragma unroll
            for (int jj = 0; jj < 4; ++jj) { const f32x4 g0 = gpre[2 * jj], g1 = gpre[2 * jj + 1];
              const f32x4 a0 = v[h][2 * jj], a1 = v[h][2 * jj + 1]; u32x4 w;
              w.x = cvt_pk_bf16(a0.x * r2 * g0.x, a0.y * r2 * g0.y); w.y = cvt_pk_bf16(a0.z * r2 * g0.z, a0.w * r2 * g0.w);
              w.z = cvt_pk_bf16(a1.x * r2 * g1.x, a1.y * r2 * g1.y); w.w = cvt_pk_bf16(a1.z * r2 * g1.z, a1.w * r2 * g1.w); ho[64 * jj] = w; }
          }
        }
      }
    }
    }
    }
  }
}

extern "C" void kernel_launch(void* const* d_in, const int* in_sizes, int n_in, void* d_out, int out_size, void* d_ws, size_t ws_size, hipStream_t stream) {
  static int grid = 0;
  if (grid == 0) {
    if (n_in != 12 || in_sizes[0] != MT * DM || out_size != MT * DM || ws_size < WS_END) {
      fprintf(stderr, "kernel_launch: shape mismatch n_in %d in0 %d out %d ws %zu (need %zu)\n", n_in, n_in > 0 ? in_sizes[0] : -1, out_size, ws_size, (size_t)WS_END); grid = -1; return; }
    int dev = 0, cus = 0, per_cu = 0;
    hipGetDevice(&dev); hipDeviceGetAttribute(&cus, hipDeviceAttributeMultiprocessorCount, dev);
    if (hipFuncSetAttribute((const void*)mega, hipFuncAttributeMaxDynamicSharedMemorySize, LDS_BYTES) != hipSuccess) { fprintf(stderr, "kernel_launch: hipFuncSetAttribute failed\n"); grid = -1; return; }
    if (hipOccupancyMaxActiveBlocksPerMultiprocessor(&per_cu, (const void*)mega, 512, LDS_BYTES) != hipSuccess || per_cu < 1) { fprintf(stderr, "kernel_launch: occupancy query gave %d\n", per_cu); per_cu = 1; }
    (void)hipGetLastError();
    if (cus < 256) { fprintf(stderr, "kernel_launch: built for a 256-CU device, found %d CUs\n", cus); grid = -1; return; }
    grid = 256;
    fprintf(stderr, "kernel_launch: cus %d per_cu %d grid %d\n", cus, per_cu, grid);
  }
  if (grid < 0) return;
  if (hipMemsetAsync((char*)d_ws + WS_BAR, 0, 16384, stream) != hipSuccess) { fprintf(stderr, "kernel_launch: memset of the barrier words failed\n"); return; }
  Args a{};
  for (int i = 0; i < 12; ++i) a.in[i] = (const float*)d_in[i];
  a.out = (float*)d_out; a.ws = (unsigned char*)d_ws;
#if MK_ONE_LAUNCH
  a.ph_lo = 0; a.ph_hi = NPHASE;
  void* args[] = {&a};
  hipError_t e = hipLaunchCooperativeKernel((const void*)mega, dim3(grid), dim3(512), args, LDS_BYTES, stream);
  if (e != hipSuccess) fprintf(stderr, "kernel_launch: cooperative launch failed: %s (grid %d)\n", hipGetErrorString(e), grid);
#else
  for (int ph = 0; ph < NPHASE; ++ph) {
    a.ph_lo = ph; a.ph_hi = ph + 1;
    hipLaunchKernelGGL(mega, dim3(grid), dim3(512), LDS_BYTES, stream, a);
  }
#endif
}
```

```cpp
#include <hip/hip_runtime.h>
#include <hip/hip_cooperative_groups.h>
#include <cstdio>
#include <cstdint>
namespace cg = cooperative_groups;

#ifndef PHMASK
#define PHMASK 0xff
#endif
#ifndef P2MASK
#define P2MASK 7
#endif
#ifndef PROBE_SUB
#define PROBE_SUB -1
#endif
#ifndef NA_SD
#define NA_SD 1
#endif
#ifndef NA_SIMPLE
#define NA_SIMPLE true
#endif
#ifndef DIL_SD
#define DIL_SD 1
#endif
#ifndef DIL_SIMPLE
#define DIL_SIMPLE true
#endif
#ifndef MK_ONE_LAUNCH
#define MK_ONE_LAUNCH 1
#endif

#define LAS __attribute__((address_space(3)))
typedef unsigned short bf16_t;
typedef short bf16x8 __attribute__((ext_vector_type(8)));
typedef short s16x4 __attribute__((ext_vector_type(4)));
typedef float f32x4 __attribute__((ext_vector_type(4)));
typedef float f32x16 __attribute__((ext_vector_type(16)));
typedef unsigned u32x4 __attribute__((ext_vector_type(4)));
typedef unsigned u32x2 __attribute__((ext_vector_type(2)));

constexpr int NB = 2, SEQ = 8192, MT = NB * SEQ, DM = 2048, NIN = 17920, DEPTH = 4, YW = 2560;
constexpr int C_QA = 0, C_KA = 1024, C_VA = 2048, C_QB = 3072, C_QC = 4608, C_KC = 6144, C_VC = 7680, C_ZA = 9216, C_ZB = 10240, C_ZC = 11264, C_G = 11776;
constexpr float EPS = 1e-6f;
constexpr size_t al256(size_t x) { return (x + 255) / 256 * 256; }
constexpr size_t WS_WIN = 0;
constexpr size_t WS_WBR = WS_WIN + al256((size_t)DEPTH * NIN * DM * 2);
constexpr size_t WS_WOUT = WS_WBR + al256((size_t)DEPTH * DM * YW * 2);
constexpr size_t WS_H = WS_WOUT + al256((size_t)DEPTH * DM * DM * 2);
constexpr size_t WS_PROJ = WS_H + al256((size_t)MT * DM * 2);
constexpr size_t WS_Y = WS_PROJ + al256((size_t)MT * NIN * 2);
constexpr size_t WS_QB = WS_Y + al256((size_t)MT * YW * 2);
constexpr size_t WS_KB = WS_QB + al256((size_t)MT * 1024 * 2);
constexpr size_t WS_VB = WS_KB + al256((size_t)MT * 256 * 2);
constexpr size_t WS_OC = WS_VB + al256((size_t)MT * 256 * 2);
constexpr size_t WS_LSE = WS_OC + al256((size_t)3 * MT * 512 * 2);
constexpr size_t WS_MRG = WS_LSE + al256((size_t)3 * MT * 4 * 4);
constexpr size_t WS_OUT = WS_MRG + al256((size_t)MT * DM * 2);
constexpr size_t WS_GF = WS_OUT + al256((size_t)MT * DM * 4);
constexpr size_t WS_BAR = WS_GF + al256((size_t)3 * MT * DM * 2);
constexpr size_t WS_END = WS_BAR + 16384;

typedef __bf16 bf16x2_t __attribute__((ext_vector_type(2)));
typedef float f32x2_t __attribute__((ext_vector_type(2)));
__device__ __forceinline__ unsigned cvt_pk_bf16(float lo, float hi) { f32x2_t v = {lo, hi}; bf16x2_t r = __builtin_convertvector(v, bf16x2_t); return __builtin_bit_cast(unsigned, r); }
__device__ __forceinline__ float bf_lo(unsigned w) { return __uint_as_float(w << 16); }
__device__ __forceinline__ float bf_hi(unsigned w) { return __uint_as_float(w & 0xffff0000u); }
__device__ __forceinline__ float bf2f(bf16_t v) { return __uint_as_float(((unsigned)v) << 16); }
__device__ __forceinline__ int opaque_v(int v) { asm volatile("" : "+v"(v)); return v; }
__device__ __forceinline__ int opaque_si(int v) { asm volatile("" : "+s"(v)); return v; }
template <class T> __device__ __forceinline__ T* opaque_s(T* p) { asm volatile("" : "+s"(p)); return p; }
__device__ __forceinline__ float sigmoidf_(float v) { return __builtin_amdgcn_rcpf(1.0f + __builtin_amdgcn_exp2f(-1.4426950408889634f * v)); }

namespace pg8 {
constexpr int BM = 256, BK = 64, HALF = 128, HTB = HALF * BK * 2, STAGE_BYTES = 8 * HTB, NXCD = 8, WGM = 8;
__host__ __device__ __forceinline__ int lds_byte(int r, int c) { const int st = (r >> 4) * 2 + (c >> 5), rr = r & 15, cc = c & 31, ob = rr * 64 + cc * 2; return st * 1024 + (ob ^ (((ob >> 9) & 1) << 5)); }
__host__ __device__ __forceinline__ void stage_rc(int b, int& R, int& C) { const int st = b / 1024, sb = b % 1024, swz = sb ^ (((sb >> 9) & 1) << 5); R = (st >> 1) * 16 + swz / 64; C = (st & 1) * 32 + (swz % 64) / 2; }
__host__ __device__ __forceinline__ int perm32(int rho) { const int n = rho >> 4, i = rho & 15; return 8 * (i >> 2) + 4 * n + (i & 3); }
struct Unit { int pm, pn; };
struct Gemm { const bf16_t* A; const bf16_t* Bt; int M, N, K, lda, ldb; };
struct StaticOrder {
    int nM, nN, nwg, G, c;
    __device__ void init(int M, int N, int G_, int c_) { nM = M / BM; nN = N / BM; nwg = nM * nN; G = G_; c = c_; }
    __device__ bool next(int i, Unit& u) const {
        const long L = (long)i * G + c; if (L >= nwg) return false;
        int wgid = (int)L; { const int q = nwg / NXCD, r = nwg % NXCD, xcd = wgid % NXCD, off = wgid / NXCD; wgid = (xcd < r ? xcd * (q + 1) : r * (q + 1) + (xcd - r) * q) + off; }
        const int nig = WGM * nN, gid = wgid / nig, fm = gid * WGM, gsz = (nM - fm) < WGM ? (nM - fm) : WGM;
        u.pm = fm + ((wgid % nig) % gsz); u.pn = (wgid % nig) / gsz; return true;
    }
};
struct EpiProj {
    static constexpr bool PERM = true, HAS_MID = false;
    bf16_t* O; const float* bgate; u32x4* GF;
    __device__ __forceinline__ void mid(f32x4 (&)[2][2][4][2], const Unit&, int, int, int, int, int) const {}
    __device__ __forceinline__ void operator()(const f32x4 (&acc)[2][2][4][2], const Unit& u, int wr, int wc, int fr, int fq) const {
        fr = opaque_v(fr); fq = opaque_v(fq);
        const int row0 = u.pm * BM + wr * 64 + fr, colt = u.pn * BM, col0 = colt + wc * 32 + 8 * fq;
        const int mode = colt < C_ZA ? 0 : (colt < C_G ? 1 : 2);
        if (mode == 2) {
            const int gt = u.pn - C_G / BM;
            u32x4* gf = GF + ((size_t)(((gt >> 3) * 64 + u.pm) * 8 + (gt & 7)) * 8 + (wr * 4 + wc)) * 1024 + fq * 16 + fr;
            f32x4 bv[2][2];
#pragma unroll
            for (int bj = 0; bj < 2; ++bj)
#pragma unroll
                for (int n = 0; n < 2; ++n) bv[bj][n] = *(const f32x4*)(bgate + (col0 - C_G) + bj * HALF + 4 * n);
#pragma unroll
            for (int ai = 0; ai < 2; ++ai)
#pragma unroll
                for (int m = 0; m < 4; ++m)
#pragma unroll
                    for (int bj = 0; bj < 2; ++bj) { const f32x4 v0 = acc[ai][bj][m][0] + bv[bj][0], v1 = acc[ai][bj][m][1] + bv[bj][1];
                        u32x4 w; w.x = cvt_pk_bf16(sigmoidf_(v0[0]), sigmoidf_(v0[1])); w.y = cvt_pk_bf16(sigmoidf_(v0[2]), sigmoidf_(v0[3]));
                        w.z = cvt_pk_bf16(sigmoidf_(v1[0]), sigmoidf_(v1[1])); w.w = cvt_pk_bf16(sigmoidf_(v1[2]), sigmoidf_(v1[3]));
                        gf[((ai * 4 + m) * 2 + bj) * 64] = w; }
            return;
        }
#pragma unroll
        for (int ai = 0; ai < 2; ++ai)
#pragma unroll
            for (int m = 0; m < 4; ++m) { bf16_t* rowp = O + (size_t)(row0 + ai * HALF + m * 16) * NIN + col0;
#pragma unroll
                for (int bj = 0; bj < 2; ++bj) { f32x4 v0 = acc[ai][bj][m][0], v1 = acc[ai][bj][m][1];
                    if (mode != 0) {
#pragma unroll
                        for (int j = 0; j < 4; ++j) { v0[j] *= sigmoidf_(v0[j]); v1[j] *= sigmoidf_(v1[j]); }
                    }
                    u32x4 w; w.x = cvt_pk_bf16(v0[0], v0[1]); w.y = cvt_pk_bf16(v0[2], v0[3]); w.z = cvt_pk_bf16(v1[0], v1[1]); w.w = cvt_pk_bf16(v1[2], v1[3]);
                    *(u32x4*)(rowp + bj * HALF) = w; } }
    }
};
struct EpiMerged {
    static constexpr bool PERM = true, HAS_MID = true;
    const u32x4* GF;
    bf16_t* O;
    __device__ __forceinline__ const u32x4* gbase(int gate, const Unit& u, int wr, int wc, int fr, int fq) const {
        return GF + ((size_t)((gate * 64 + u.pm) * 8 + u.pn) * 8 + (wr * 4 + wc)) * 1024 + fq * 16 + fr; }
    __device__ __forceinline__ void mid(f32x4 (&acc)[2][2][4][2], const Unit& u, int t, int wr, int wc, int fr, int fq) const {
        fr = opaque_v(fr); fq = opaque_v(fq);
        const int gn = (t == 16) ? 0 : 1;
        const u32x4* pa = gbase(gn, u, wr, wc, fr, fq); const u32x4* pb = gbase(gn + 1, u, wr, wc, fr, fq);
        u32x4 a0[4], b0[4], a1[4], b1[4];
#define GF_LD(A, B, H) _Pragma("unroll") for (int k = 0; k < 4; ++k) { A[k] = pa[((H) * 4 + k) * 64]; B[k] = pb[((H) * 4 + k) * 64]; }
#define GF_USE(A, B, H) _Pragma("unroll") for (int k = 0; k < 4; ++k) { const int f = (H) * 4 + k, ai = f >> 3, m = (f >> 1) & 3, bj = f & 1; \
            _Pragma("unroll") for (int q = 0; q < 4; ++q) { const float r0 = bf_lo(A[k][q]) * __builtin_amdgcn_rcpf(fmaxf(bf_lo(B[k][q]), 1e-30f)), r1 = bf_hi(A[k][q]) * __builtin_amdgcn_rcpf(fmaxf(bf_hi(B[k][q]), 1e-30f)); \
                acc[ai][bj][m][q >> 1][(q & 1) * 2] *= r0; acc[ai][bj][m][q >> 1][(q & 1) * 2 + 1] *= r1; } }
        GF_LD(a0, b0, 0) GF_LD(a1, b1, 1)
        asm volatile("" ::: "memory");
        GF_USE(a0, b0, 0) GF_LD(a0, b0, 2)
        asm volatile("" ::: "memory");
        GF_USE(a1, b1, 1) GF_LD(a1, b1, 3)
        asm volatile("" ::: "memory");
        GF_USE(a0, b0, 2)
        GF_USE(a1, b1, 3)
#undef GF_LD
#undef GF_USE
    }
    __device__ __forceinline__ void operator()(const f32x4 (&acc)[2][2][4][2], const Unit& u, int wr, int wc, int fr, int fq) const {
        fr = opaque_v(fr); fq = opaque_v(fq);
        const int row0 = u.pm * BM + wr * 64 + fr, col0 = u.pn * BM + wc * 32 + 8 * fq;
        const u32x4* pc = gbase(2, u, wr, wc, fr, fq);
#pragma unroll
        for (int h = 0; h < 2; ++h) {
            u32x4 c[8];
#pragma unroll
            for (int k = 0; k < 8; ++k) c[k] = pc[(h * 8 + k) * 64];
            asm volatile("" ::: "memory");
#pragma unroll
            for (int k = 0; k < 8; ++k) { const int f = h * 8 + k, ai = f >> 3, m = (f >> 1) & 3, bj = f & 1;
                bf16_t* rowp = O + (size_t)(row0 + ai * HALF + m * 16) * DM + col0; const f32x4 v0 = acc[ai][bj][m][0], v1 = acc[ai][bj][m][1];
                u32x4 w; w.x = cvt_pk_bf16(v0[0] * bf_lo(c[k].x), v0[1] * bf_hi(c[k].x)); w.y = cvt_pk_bf16(v0[2] * bf_lo(c[k].y), v0[3] * bf_hi(c[k].y));
                w.z = cvt_pk_bf16(v1[0] * bf_lo(c[k].z), v1[1] * bf_hi(c[k].z)); w.w = cvt_pk_bf16(v1[2] * bf_lo(c[k].w), v1[3] * bf_hi(c[k].w));
                *(u32x4*)(rowp + bj * HALF) = w; }
        }
    }
};
struct EpiF32 {
    static constexpr bool PERM = true, HAS_MID = false;
    bf16_t* O; int ldc;
    __device__ __forceinline__ void mid(f32x4 (&)[2][2][4][2], const Unit&, int, int, int, int, int) const {}
    __device__ __forceinline__ void operator()(const f32x4 (&acc)[2][2][4][2], const Unit& u, int wr, int wc, int fr, int fq) const {
        fr = opaque_v(fr); fq = opaque_v(fq);
        const int row0 = u.pm * BM + wr * 64 + fr, col0 = u.pn * BM + wc * 32 + 8 * fq;
#pragma unroll
        for (int ai = 0; ai < 2; ++ai)
#pragma unroll
            for (int m = 0; m < 4; ++m) { bf16_t* rowp = O + (size_t)(row0 + ai * HALF + m * 16) * ldc + col0;
#pragma unroll
                for (int bj = 0; bj < 2; ++bj) { const f32x4 v0 = acc[ai][bj][m][0], v1 = acc[ai][bj][m][1];
                    u32x4 w; w.x = cvt_pk_bf16(v0[0], v0[1]); w.y = cvt_pk_bf16(v0[2], v0[3]); w.z = cvt_pk_bf16(v1[0], v1[1]); w.w = cvt_pk_bf16(v1[2], v1[3]);
                    *(u32x4*)(rowp + bj * HALF) = w; } }
    }
};

template <class Epi, class Sched>
__device__ __forceinline__ void gemm_phase(LAS unsigned char* lds, const Gemm g, const Sched& S, const Epi& E, const int tid) {
    const int wid = __builtin_amdgcn_readfirstlane(tid >> 6), lane = tid & 63, wr = wid >> 2, wc = wid & 3, fr = lane & 15, fq = lane >> 4;
    const int K = g.K, nt = K / BK;
    unsigned voffA[2], voffB[2];
#pragma unroll
    for (int i = 0; i < 2; ++i) { int R, C; stage_rc(tid * 16 + i * 8192, R, C); const int Rb = Epi::PERM ? ((R & ~31) + perm32(R & 31)) : R;
        voffA[i] = (unsigned)(R * g.lda + C) * 2u; voffB[i] = (unsigned)(Rb * g.ldb + C) * 2u; }
    const size_t kstep = (size_t)(BK * 2);
    const size_t hstepA = (size_t)HALF * g.lda * 2, hstepB = (size_t)HALF * g.ldb * 2;
    const size_t tstepA = 2 * hstepA, tstepB = 2 * hstepB;
    const unsigned ldsw = (unsigned)wid * 1024u;
    const int aoff = lds_byte(wr * 64 + fr, fq * 8), boff = lds_byte(wc * 32 + fr, fq * 8);
#define PG8_SA(b, h) (((b) * 2 + (h)) * HTB)
#define PG8_SB(b, h) ((4 + (b) * 2 + (h)) * HTB)
#define PG8_STAGE(bufoff, gbase, voff) do { _Pragma("unroll") for (int _i = 0; _i < 2; ++_i) \
        __builtin_amdgcn_global_load_lds((const unsigned*)((const char*)(gbase) + (voff)[_i]), (LAS unsigned*)(lds + (bufoff) + ldsw + _i * 8192), 16, 0, 0); } while (0)
#define PG8_LDA(dst, b, h) do { _Pragma("unroll") for (int m = 0; m < 4; ++m) _Pragma("unroll") for (int k = 0; k < 2; ++k) dst[m][k] = *(const LAS bf16x8*)(lds + PG8_SA(b, h) + aoff + m * 2048 + k * 1024); } while (0)
#define PG8_LDB(dst, b, h) do { _Pragma("unroll") for (int n = 0; n < 2; ++n) _Pragma("unroll") for (int k = 0; k < 2; ++k) dst[n][k] = *(const LAS bf16x8*)(lds + PG8_SB(b, h) + boff + n * 2048 + k * 1024); } while (0)
#define PG8_MMA(ai, bj, At, Bt) do { __builtin_amdgcn_s_setprio(1); _Pragma("unroll") for (int m = 0; m < 4; ++m) _Pragma("unroll") for (int n = 0; n < 2; ++n) _Pragma("unroll") for (int k = 0; k < 2; ++k) \
        acc[ai][bj][m][n] = __builtin_amdgcn_mfma_f32_16x16x32_bf16(Bt[n][k], At[m][k], acc[ai][bj][m][n], 0, 0, 0); __builtin_amdgcn_s_setprio(0); } while (0)
#define PG8_WAIT_V(n) asm volatile("s_waitcnt vmcnt(" #n ")" ::: "memory")
#define PG8_WAIT_L(n) asm volatile("s_waitcnt lgkmcnt(" #n ")" ::: "memory")
#define PG8_BAR __builtin_amdgcn_s_barrier()
#define PG8_SCHED __builtin_amdgcn_sched_barrier(0)
    Unit cur, nxt; int ui = 0;
    if (!S.next(0, cur)) return;
    f32x4 acc[2][2][4][2];
#pragma unroll
    for (int a = 0; a < 2; ++a)
#pragma unroll
        for (int b = 0; b < 2; ++b)
#pragma unroll
            for (int m = 0; m < 4; ++m)
#pragma unroll
                for (int n = 0; n < 2; ++n) acc[a][b][m][n] = (f32x4){0.f, 0.f, 0.f, 0.f};
    bf16x8 At[4][2], B0[2][2], B1[2][2];
    const char* cA = (const char*)g.A + (size_t)cur.pm * tstepA; const char* cB = (const char*)g.Bt + (size_t)cur.pn * tstepB;
    PG8_STAGE(PG8_SB(0, 0), cB, voffB); PG8_STAGE(PG8_SB(0, 1), cB + hstepB, voffB); PG8_STAGE(PG8_SA(0, 0), cA, voffA); PG8_STAGE(PG8_SA(0, 1), cA + hstepA, voffA);
    if (wr == 1) PG8_BAR;
    PG8_WAIT_V(2); PG8_BAR;
    PG8_STAGE(PG8_SB(1, 0), cB + kstep, voffB); PG8_STAGE(PG8_SA(1, 0), cA + kstep, voffA); PG8_STAGE(PG8_SB(1, 1), cB + hstepB + kstep, voffB);
    PG8_WAIT_V(6); PG8_BAR;
    for (;;) {
        const bool has_next = S.next(ui + 1, nxt);
        const char* nA = has_next ? (const char*)g.A + (size_t)nxt.pm * tstepA : cA; const char* nB = has_next ? (const char*)g.Bt + (size_t)nxt.pn * tstepB : cB;
        for (int t = 0; t < nt; t += 2) {
            const bool last = (t == nt - 2);
            const char* a1 = cA + (size_t)(t + 1) * kstep;
            const char* a2 = last ? nA : cA + (size_t)(t + 2) * kstep; const char* b2 = last ? nB : cB + (size_t)(t + 2) * kstep;
            const char* a3 = a2 + kstep; const char* b3 = b2 + kstep;
            if constexpr (Epi::HAS_MID) { if (t == 16 || t == 32) E.mid(acc, cur, t, wr, wc, fr, fq); }
            PG8_LDB(B0, 0, 0); PG8_LDB(B1, 0, 1); PG8_SCHED; PG8_LDA(At, 0, 0); PG8_STAGE(PG8_SA(1, 1), a1 + hstepA, voffA);
            PG8_WAIT_V(8); PG8_WAIT_L(0); PG8_BAR; PG8_MMA(0, 0, At, B0); PG8_MMA(0, 1, At, B1); PG8_BAR; PG8_SCHED;
            PG8_LDA(At, 0, 1); PG8_STAGE(PG8_SB(0, 0), b2, voffB); PG8_STAGE(PG8_SB(0, 1), b2 + hstepB, voffB); PG8_STAGE(PG8_SA(0, 0), a2, voffA);
            PG8_WAIT_V(8); PG8_WAIT_L(0); PG8_BAR; PG8_MMA(1, 0, At, B0); PG8_MMA(1, 1, At, B1); PG8_BAR; PG8_SCHED;
            PG8_LDB(B0, 1, 0); PG8_LDB(B1, 1, 1); PG8_SCHED; PG8_LDA(At, 1, 0); PG8_STAGE(PG8_SA(0, 1), a2 + hstepA, voffA);
            PG8_WAIT_V(8); PG8_WAIT_L(0); PG8_BAR; PG8_MMA(0, 0, At, B0); PG8_MMA(0, 1, At, B1); PG8_BAR; PG8_SCHED;
            PG8_LDA(At, 1, 1); PG8_STAGE(PG8_SB(1, 0), b3, voffB); PG8_STAGE(PG8_SB(1, 1), b3 + hstepB, voffB); PG8_STAGE(PG8_SA(1, 0), a3, voffA);
            PG8_WAIT_V(8); PG8_WAIT_L(0); PG8_BAR; PG8_MMA(1, 0, At, B0); PG8_MMA(1, 1, At, B1); PG8_BAR; PG8_SCHED;
        }
        if (wr == 0) PG8_BAR;
        E(acc, cur, wr, wc, fr, fq);
        if (!has_next) break;
#pragma unroll
        for (int a = 0; a < 2; ++a)
#pragma unroll
            for (int b = 0; b < 2; ++b)
#pragma unroll
                for (int m = 0; m < 4; ++m)
#pragma unroll
                    for (int n = 0; n < 2; ++n) acc[a][b][m][n] = (f32x4){0.f, 0.f, 0.f, 0.f};
        cur = nxt; cA = nA; cB = nB; ++ui;
        if (wr == 1) PG8_BAR;
    }
    PG8_WAIT_V(0);
    PG8_BAR;
#undef PG8_SA
#undef PG8_SB
#undef PG8_STAGE
#undef PG8_LDA
#undef PG8_LDB
#undef PG8_MMA
#undef PG8_WAIT_V
#undef PG8_WAIT_L
#undef PG8_BAR
#undef PG8_SCHED
}
}

namespace att {
constexpr int D = 128, NW = 8, QBLK = 32, KVBLK = 64;
constexpr float SCALE = 0.088388347648318440f, ISCALE = 11.313708498984761f;
constexpr float THR = 8.f, NEG = -30000.f;
constexpr size_t SHM_V = KVBLK * D * 2, SHM_K = KVBLK * D * 2, SHM_WS = 71680  , SHM_TBL = SHM_WS + NW * 64 * 4 + 256, SHM_ATTN = SHM_TBL + 2560;
#define KSWZ(row, colB) ((row) * 256 + ((colB) ^ (((row) & 7) << 4)))
#define SBAR() __builtin_amdgcn_sched_barrier(0)
__device__ __forceinline__ int crow(int r, int hi) { return (r & 3) + 8 * (r >> 2) + 4 * hi; }
__device__ __forceinline__ void partialSM(f32x16& p0, f32x16& p1, float& m_reg, float& mn, float& alpha) {
  constexpr float C = SCALE * 1.4426950408889634f;
  float pmax = p0[0];
#pragma unroll
  for (int r = 1; r < 16; ++r) pmax = fmaxf(pmax, p0[r]);
#pragma unroll
  for (int r = 0; r < 16; ++r) pmax = fmaxf(pmax, p1[r]);
  { auto rr = __builtin_amdgcn_permlane32_swap(__float_as_uint(pmax), __float_as_uint(pmax), false, false);
    pmax = fmaxf(__uint_as_float(rr[0]), __uint_as_float(rr[1])); }
  if (__builtin_expect(__all(pmax - m_reg <= THR / SCALE), 1)) { mn = m_reg; alpha = 1.f; }
  else { mn = fmaxf(m_reg, pmax); alpha = __builtin_amdgcn_exp2f((m_reg - mn) * C); m_reg = mn; }
  float mnC = -mn * C;
#pragma unroll
  for (int r = 0; r < 16; ++r) p0[r] = fmaf(p0[r], C, mnC);
#pragma unroll
  for (int r = 0; r < 16; ++r) p1[r] = fmaf(p1[r], C, mnC);
#pragma unroll
  for (int r = 0; r < 16; ++r) p0[r] = __builtin_amdgcn_exp2f(p0[r]);
}
__device__ __forceinline__ void finishSM(f32x16& p0, f32x16& p1, float alpha, float& l_reg, bf16x8& pa0, bf16x8& pa1, bf16x8& pa2, bf16x8& pa3) {
#pragma unroll
  for (int r = 0; r < 16; ++r) p1[r] = __builtin_amdgcn_exp2f(p1[r]);
  float ps = 0;
#pragma unroll
  for (int r = 0; r < 16; ++r) ps += p0[r];
#pragma unroll
  for (int r = 0; r < 16; ++r) ps += p1[r];
  { auto rr = __builtin_amdgcn_permlane32_swap(__float_as_uint(ps), __float_as_uint(ps), false, false);
    ps = __uint_as_float(rr[0]) + __uint_as_float(rr[1]); }
  l_reg = l_reg * alpha + ps;
#define PK4(P, BASE, OUT) do { unsigned a0 = cvt_pk_bf16(P[BASE + 0], P[BASE + 1]), a1 = cvt_pk_bf16(P[BASE + 2], P[BASE + 3]);   \
    unsigned b0 = cvt_pk_bf16(P[BASE + 4], P[BASE + 5]), b1 = cvt_pk_bf16(P[BASE + 6], P[BASE + 7]);                              \
    auto r0 = __builtin_amdgcn_permlane32_swap(a0, b0, false, false); auto r1 = __builtin_amdgcn_permlane32_swap(a1, b1, false, false); \
    u32x4 w = {r0[0], r1[0], r0[1], r1[1]}; OUT = *reinterpret_cast<bf16x8*>(&w); } while (0)
  PK4(p0, 0, pa0); PK4(p0, 8, pa1); PK4(p1, 0, pa2); PK4(p1, 8, pa3);
#undef PK4
}
__device__ __forceinline__ void qkt(f32x16& p0, f32x16& p1, const char* Ks, const bf16x8* qr, int r32, int hi) {
  p0 = f32x16{}; p1 = f32x16{};
#pragma unroll
  for (int d0 = 0; d0 < 8; ++d0) { int cb = (d0 * 16 + hi * 8) * 2;
    bf16x8 b0 = *reinterpret_cast<const bf16x8*>(Ks + KSWZ(r32, cb));
    bf16x8 b1 = *reinterpret_cast<const bf16x8*>(Ks + KSWZ(32 + r32, cb));
    p0 = __builtin_amdgcn_mfma_f32_32x32x16_bf16(b0, qr[d0], p0, 0, 0, 0);
    p1 = __builtin_amdgcn_mfma_f32_32x32x16_bf16(b1, qr[d0], p1, 0, 0, 0); }
}
__device__ __forceinline__ int v_st(int k, int c) { const int kk = (k & ~0xC) | ((k & 4) << 1) | ((k & 8) >> 1); return ((kk >> 3) * 4 + (c >> 5)) * 512 + ((kk & 7) * 32 + (c & 31)) * 2; }
__device__ __forceinline__ int v_rd_base(int lane) { return ((lane & 3) << 3) | (((lane >> 2) & 3) << 6) | (((lane >> 4) & 1) << 5) | (((lane >> 5) & 1) << 8); }
constexpr int v_rd_off(int d0, int ks, int half) { return d0 * 512 + ks * 4096 + half * 2048; }
template <int OFF> __device__ __forceinline__ s16x4 tr_read(int vb) {
  s16x4 r; asm volatile("ds_read_b64_tr_b16 %0, %1 offset:%2" : "=&v"(r) : "v"(vb), "i"(OFF) : "memory"); return r;
}
template <int D0> __device__ __forceinline__ void pv_one(f32x16& od, int vb, bf16x8 pa0, bf16x8 pa1, bf16x8 pa2, bf16x8 pa3) {
  const s16x4 l0 = tr_read<v_rd_off(D0, 0, 0)>(vb), h0 = tr_read<v_rd_off(D0, 0, 1)>(vb), l1 = tr_read<v_rd_off(D0, 1, 0)>(vb), h1 = tr_read<v_rd_off(D0, 1, 1)>(vb);
  const s16x4 l2 = tr_read<v_rd_off(D0, 2, 0)>(vb), h2 = tr_read<v_rd_off(D0, 2, 1)>(vb), l3 = tr_read<v_rd_off(D0, 3, 0)>(vb), h3 = tr_read<v_rd_off(D0, 3, 1)>(vb);
  asm volatile("s_waitcnt lgkmcnt(0)" ::: "memory"); SBAR();
#define PK(L, H) (bf16x8){L[0], L[1], L[2], L[3], H[0], H[1], H[2], H[3]}
  od = __builtin_amdgcn_mfma_f32_32x32x16_bf16(pa0, PK(l0, h0), od, 0, 0, 0);
  od = __builtin_amdgcn_mfma_f32_32x32x16_bf16(pa1, PK(l1, h1), od, 0, 0, 0);
  od = __builtin_amdgcn_mfma_f32_32x32x16_bf16(pa2, PK(l2, h2), od, 0, 0, 0);
  od = __builtin_amdgcn_mfma_f32_32x32x16_bf16(pa3, PK(l3, h3), od, 0, 0, 0);
#undef PK
}
__device__ __forceinline__ void pv_d0(f32x16* o, int vb, bf16x8 pa0, bf16x8 pa1, bf16x8 pa2, bf16x8 pa3) {
  pv_one<0>(o[0], vb, pa0, pa1, pa2, pa3); pv_one<1>(o[1], vb, pa0, pa1, pa2, pa3); pv_one<2>(o[2], vb, pa0, pa1, pa2, pa3); pv_one<3>(o[3], vb, pa0, pa1, pa2, pa3);
}

struct Unit {
  const bf16_t* Q; const bf16_t* K; const bf16_t* V;
  int ldq, ldk;
  int NT;
  bf16_t* O; int ldo;
  const bf16_t* Z; int ldz;
  float* LSE; int ldl;
  int qr, kr0;
  int i0, k0; float slope;
};

template <int MODE>
__device__ __forceinline__ void amask(f32x16& p0, f32x16& p1, int j, const Unit& U, int wid, int r32, int hi, const float* tbl) {
  if constexpr (MODE == 1) {
    const int qrow = U.qr + (wid >> 1), kr = U.kr0 + j, st = min(max(qrow - 4, 0), 120);
    if (kr < st || kr >= st + 8) {
#pragma unroll
      for (int r = 0; r < 16; ++r) { p0[r] = NEG; p1[r] = NEG; }
    } else {
      const int jq = (wid & 1) * 32 + r32, cs = min(max(jq - 8, 0), 48);
      const float* tr = tbl + (kr - qrow + 7) * 31 + (15 - jq);
#pragma unroll
      for (int r2 = 0; r2 < 8; ++r2) {
        float b0[2], b1[2];
#pragma unroll
        for (int q = 0; q < 2; ++q) { const int c = crow(r2 * 2 + q, hi); b0[q] = tr[c]; b1[q] = tr[c + 32]; }
        asm volatile("" ::: "memory");
#pragma unroll
        for (int q = 0; q < 2; ++q) { const int r = r2 * 2 + q, c = crow(r, hi);
          p0[r] = ((unsigned)(c - cs) < 16u) ? p0[r] + b0[q] : NEG;
          p1[r] = ((unsigned)(c + 32 - cs) < 16u) ? p1[r] + b1[q] : NEG; }
      }
    }
  } else if constexpr (MODE == 2) {
    const int base = U.k0 + j * 64 - (U.i0 + wid * 32 + r32);
#pragma unroll
    for (int r = 0; r < 16; ++r) { const int c = crow(r, hi); const int d0 = abs(base + c), d1 = abs(base + c + 32);
      p0[r] = (d0 <= 64) ? p0[r] - U.slope * (float)d0 : NEG;
      p1[r] = (d1 <= 64) ? p1[r] - U.slope * (float)d1 : NEG; }
  }
}

template <int MODE, int SDEPTH, bool SIMPLE>
__device__ __forceinline__ void attn_body(const Unit& U, char* lds, const int tid) {
  const int wid = tid >> 6, lane = tid & 63, r32 = lane & 31, hi = lane >> 5;
  char* V_lds = lds; char* K_lds = lds + 2 * SHM_V;
  float* ws = (float*)(lds + SHM_WS) + wid * 64; float* li_l = ws; float* al_l = ws + 32;
  const float* tbl = (const float*)(lds + SHM_TBL);
  float m_reg = -1e30f, l_reg = 0; f32x16 o[4] = {}; bf16x8 qr[8];
  const bf16_t* Qw = U.Q + (long)(wid * QBLK + r32) * U.ldq + hi * 8;
#pragma unroll
  for (int d0 = 0; d0 < 8; ++d0) qr[d0] = *reinterpret_cast<const bf16x8*>(Qw + d0 * 16);
  const int sr = tid >> 4, sc = (tid & 15) * 8, vst0 = v_st(sr, sc), vst1 = v_st(32 + sr, sc);
  const int vb0 = (int)(uintptr_t)V_lds + v_rd_base(lane);
  const bf16_t* Kh = U.K; const bf16_t* Vh = U.V; const int LDK = U.ldk;
  struct { bf16x8 vs0, vs1, ks0, ks1; } sr_[SDEPTH];
#define SLOAD(i, k0) do { sr_[i].vs0 = *(const bf16x8*)(&Vh[(long)((k0) + sr) * LDK + sc]); sr_[i].vs1 = *(const bf16x8*)(&Vh[(long)((k0) + 32 + sr) * LDK + sc]); \
    sr_[i].ks0 = *(const bf16x8*)(&Kh[(long)((k0) + sr) * LDK + sc]); sr_[i].ks1 = *(const bf16x8*)(&Kh[(long)((k0) + 32 + sr) * LDK + sc]); } while (0)
#define SWRITE(b, i) do { *(bf16x8*)(V_lds + (b) * SHM_V + vst0) = sr_[i].vs0;          \
    *(bf16x8*)(V_lds + (b) * SHM_V + vst1) = sr_[i].vs1; int kc = sc * 2;               \
    *(bf16x8*)(K_lds + (b) * SHM_K + KSWZ(sr, kc)) = sr_[i].ks0;                       \
    *(bf16x8*)(K_lds + (b) * SHM_K + KSWZ(32 + sr, kc)) = sr_[i].ks1; } while (0)
#define SWAIT() do { if constexpr (SDEPTH == 2) asm volatile("s_waitcnt vmcnt(4)" ::: "memory"); else asm volatile("s_waitcnt vmcnt(0)" ::: "memory"); } while (0)
#define RESC(a) do { if (__any((a) < 1.f)) { if (hi == 0) al_l[r32] = (a); asm volatile("s_waitcnt lgkmcnt(0)" ::: "memory"); \
    _Pragma("unroll") for (int d = 0; d < 4; ++d) _Pragma("unroll") for (int r = 0; r < 16; ++r) o[d][r] *= al_l[crow(r, hi)]; } } while (0)
  bf16x8 pa0, pa1, pa2, pa3; const int NT = U.NT;
  if constexpr (SIMPLE) {
    f32x16 p0, p1; float mn, al;
    SLOAD(0, 0);
    for (int j = 0; j < NT; ++j) {
      asm volatile("s_waitcnt vmcnt(0)" ::: "memory"); __syncthreads(); SWRITE(0, 0);
      if (j + 1 < NT) SLOAD(0, (j + 1) * KVBLK);
      __syncthreads();
      bool act = true;
      if constexpr (MODE == 1) { const int qrow = U.qr + (wid >> 1), kr = U.kr0 + j, st = min(max(qrow - 4, 0), 120); act = (kr >= st) && (kr < st + 8); }
      if constexpr (MODE == 2) { const int q0 = U.i0 + wid * 32, t0 = U.k0 + j * 64; act = (t0 + 63 >= q0 - 64) && (t0 <= q0 + 31 + 64); }
      if (act) {
        qkt(p0, p1, K_lds, qr, r32, hi); amask<MODE>(p0, p1, j, U, wid, r32, hi, tbl);
        partialSM(p0, p1, m_reg, mn, al); finishSM(p0, p1, al, l_reg, pa0, pa1, pa2, pa3);
        RESC(al); SBAR();
        pv_d0(o, vb0, pa0, pa1, pa2, pa3);
      }
    }
  } else {
  f32x16 pA0, pA1, pB0, pB1; float mnA, mnB, alA, alB;
  constexpr int SE = 0, SO = SDEPTH - 1;
  SLOAD(SE, 0); asm volatile("s_waitcnt vmcnt(0)" ::: "memory"); SWRITE(0, SE); __syncthreads();
  qkt(pA0, pA1, K_lds, qr, r32, hi); amask<MODE>(pA0, pA1, 0, U, wid, r32, hi, tbl); partialSM(pA0, pA1, m_reg, mnA, alA);
  SLOAD(SO, KVBLK); if constexpr (SDEPTH == 2) { if (2 < NT) SLOAD(SE, 2 * KVBLK); }
  SWAIT(); SWRITE(1, SO); __syncthreads();
  for (int j = 1; j + 1 < NT; j += 2) {
    SBAR(); qkt(pB0, pB1, K_lds + SHM_K, qr, r32, hi); amask<MODE>(pB0, pB1, j, U, wid, r32, hi, tbl);
    finishSM(pA0, pA1, alA, l_reg, pa0, pa1, pa2, pa3); SBAR();
    SLOAD(SO, (j + SDEPTH) * KVBLK); SBAR();
    pv_d0(o, vb0, pa0, pa1, pa2, pa3); partialSM(pB0, pB1, m_reg, mnB, alB);
    __syncthreads(); SWAIT(); SWRITE(0, SE);
    RESC(alB); __syncthreads();
    SBAR(); qkt(pA0, pA1, K_lds, qr, r32, hi); amask<MODE>(pA0, pA1, j + 1, U, wid, r32, hi, tbl);
    finishSM(pB0, pB1, alB, l_reg, pa0, pa1, pa2, pa3); SBAR();
    if (SDEPTH == 1 || j + 3 < NT) SLOAD(SE, (j + 1 + SDEPTH) * KVBLK); SBAR();
    pv_d0(o, vb0 + (int)SHM_V, pa0, pa1, pa2, pa3); partialSM(pA0, pA1, m_reg, mnA, alA);
    __syncthreads(); SWAIT(); SWRITE(1, SO);
    RESC(alA); __syncthreads();
  }
  SBAR(); qkt(pB0, pB1, K_lds + SHM_K, qr, r32, hi); amask<MODE>(pB0, pB1, NT - 1, U, wid, r32, hi, tbl);
  finishSM(pA0, pA1, alA, l_reg, pa0, pa1, pa2, pa3); SBAR();
  pv_d0(o, vb0, pa0, pa1, pa2, pa3); partialSM(pB0, pB1, m_reg, mnB, alB);
  __syncthreads(); RESC(alB);
  finishSM(pB0, pB1, alB, l_reg, pa0, pa1, pa2, pa3); SBAR();
  pv_d0(o, vb0 + (int)SHM_V, pa0, pa1, pa2, pa3);
  }
  if (hi == 0) li_l[r32] = l_reg; asm volatile("s_waitcnt lgkmcnt(0)" ::: "memory");
  if constexpr (MODE == 2) { if (hi == 0) U.LSE[(long)(wid * QBLK + r32) * U.ldl] = m_reg * SCALE + __logf(l_reg); }
  __syncthreads();
  constexpr int OP = 136;
  bf16_t* ol = (bf16_t*)lds + wid * (32 * OP);
#pragma unroll
  for (int r = 0; r < 16; ++r) { const float rl = __builtin_amdgcn_rcpf(li_l[crow(r, hi)]); bf16_t* op = ol + crow(r, hi) * OP + r32;
#pragma unroll
    for (int d0 = 0; d0 < 4; ++d0) op[d0 * 32] = (bf16_t)(cvt_pk_bf16(o[d0][r] * rl, 0.f) & 0xffffu); }
  asm volatile("s_waitcnt lgkmcnt(0)" ::: "memory");
  { const int cc = (lane & 15) * 8, rb = lane >> 4;
    u32x4 zz[8];
    if constexpr (MODE != 2) {
#pragma unroll
      for (int i = 0; i < 8; ++i) zz[i] = *(const u32x4*)(U.Z + (long)(wid * QBLK + rb + 4 * i) * U.ldz + cc);
    }
#pragma unroll
    for (int i = 0; i < 8; ++i) { const int row = rb + 4 * i; const long orow = wid * QBLK + row;
      u32x4 v = *(const u32x4*)(ol + row * OP + cc);
      if constexpr (MODE != 2) { const u32x4 z = zz[i];
#pragma unroll
        for (int q = 0; q < 4; ++q) v[q] = cvt_pk_bf16(bf_lo(v[q]) * bf_lo(z[q]), bf_hi(v[q]) * bf_hi(z[q])); }
      *(u32x4*)(U.O + orow * U.ldo + cc) = v; } }
#undef SLOAD
#undef SWRITE
#undef SWAIT
#undef RESC
}
}

#define XB_TMO      128
#define XB_XCNT(j)  (256  + 64 * (j))
#define XB_XSUB(j)  (1280 + 64 * (j))
#define XB_XGEN(j)  (2304 + 64 * (j))
#define XB_TOP      3328
#define XB_TOPGEN   3392
#define XCD_BAR_WORDS 3456
#define XB_SPIN_CAP (1u << 18)

__device__ __forceinline__ unsigned xb_ld(unsigned* p)              { return __hip_atomic_load(p, __ATOMIC_RELAXED, __HIP_MEMORY_SCOPE_AGENT); }
__device__ __forceinline__ unsigned xb_add(unsigned* p, unsigned v) { return __hip_atomic_fetch_add(p, v, __ATOMIC_RELAXED, __HIP_MEMORY_SCOPE_AGENT); }
__device__ __forceinline__ unsigned xb_xcc_id() { return (unsigned)__builtin_amdgcn_s_getreg((3 << 11) | 20) & 0xFu; }
#define XB_SPIN(cond, bar) do { unsigned _sp = 0; while (cond) { __builtin_amdgcn_s_sleep(1); \
    if ((++_sp & 255u) == 0u) { if (xb_ld(&(bar)[XB_TMO])) break; if (_sp > XB_SPIN_CAP) { atomicAdd(&(bar)[XB_TMO], 1u); break; } } } } while (0)

struct XcdBarrier {
    unsigned* bar; unsigned x;
    volatile LAS unsigned* st;
};

__device__ __forceinline__ XcdBarrier xcd_barrier_post(unsigned* bar, volatile LAS unsigned* st) {
    XcdBarrier b; b.bar = bar; b.x = xb_xcc_id(); b.st = st;
    if (threadIdx.x == 0) (void)xb_add(&bar[XB_XCNT(b.x)], 1u);
    return b;
}
__device__ __forceinline__ void xcd_barrier_complete(unsigned* bar, unsigned x, unsigned& nloc, unsigned& nx) {
    const unsigned G = gridDim.x * gridDim.y * gridDim.z;
    unsigned sum, cnt, mine, sp = 0u;
    for (;;) {
        sum = 0u; cnt = 0u; mine = 0u;
#pragma unroll
        for (unsigned j = 0; j < 16; ++j) { const unsigned c = xb_ld(&bar[XB_XCNT(j)]); sum += c; cnt += (c > 0u) ? 1u : 0u; mine = (j == x) ? c : mine; }
        if (sum == G) break;
        __builtin_amdgcn_s_sleep(1);
        if ((++sp & 255u) == 0u) { if (xb_ld(&bar[XB_TMO])) break; if (sp > XB_SPIN_CAP) { atomicAdd(&bar[XB_TMO], 1u); break; } }
    }
    nloc = mine > 0u ? mine : 1u; nx = cnt > 0u ? cnt : 1u;
}

__device__ __forceinline__ void xcd_barrier(const XcdBarrier& b) {
    asm volatile("s_waitcnt vmcnt(0)" ::: "memory");
    __syncthreads();
    if (threadIdx.x == 0) {
        unsigned* bar = b.bar;
        __builtin_amdgcn_s_waitcnt(0);
        unsigned nloc = b.st[0], nx = b.st[1];
        if (nloc == 0u) { xcd_barrier_complete(bar, b.x, nloc, nx); b.st[0] = nloc; b.st[1] = nx; }
        const unsigned old = xb_add(&bar[XB_XSUB(b.x)], 1u);
        const unsigned gen = old / nloc;
        if (old + 1u == (gen + 1u) * nloc) {
            __builtin_amdgcn_fence(__ATOMIC_RELEASE, "agent");
            asm volatile("s_waitcnt vmcnt(0)" ::: "memory");
            const unsigned og = xb_add(&bar[XB_TOP], 1u);
            const unsigned tg = og / nx;
            if (og + 1u == (tg + 1u) * nx) xb_add(&bar[XB_TOPGEN], 1u);
            else XB_SPIN(xb_ld(&bar[XB_TOPGEN]) == tg, bar);
            __builtin_amdgcn_fence(__ATOMIC_ACQUIRE, "agent");
            xb_add(&bar[XB_XGEN(b.x)], 1u);
            asm volatile("s_waitcnt vmcnt(0)" ::: "memory");
        } else {
            XB_SPIN(xb_ld(&bar[XB_XGEN(b.x)]) == gen, bar);
            __builtin_amdgcn_fence(__ATOMIC_ACQUIRE, "agent");
            asm volatile("s_waitcnt vmcnt(0)" ::: "memory");
        }
    }
    __syncthreads();
}


constexpr int LDS_BYTES = 128 * 1024 + 256;
static_assert(att::SHM_ATTN <= 128 * 1024 && pg8::STAGE_BYTES <= 128 * 1024 && XCD_BAR_WORDS * 4 <= 16384, "LDS");
struct Args { const float* in[12]; float* out; unsigned char* ws; int ph_lo, ph_hi; };
constexpr int NPHASE = 1 + 6 * DEPTH;

__device__ __forceinline__ float wave_sum(float v) {
#pragma unroll
  for (int o = 1; o < 64; o <<= 1) v += __shfl_xor(v, o);
  return v;
}
struct TrItem { const float* W; bf16_t* WT; int N, ldt, koff, item; };
__device__ __forceinline__ void tr_load(const TrItem& t, int lane, float (&v)[32]) {
  const int nblk = t.N / 32, kb = t.item / nblk, nb = t.item % nblk, k0 = 64 * kb, n0 = 32 * nb;
  const float* p = t.W + (size_t)(k0 + (lane >> 5)) * t.N + n0 + (lane & 31);
#pragma unroll
  for (int i = 0; i < 32; ++i) v[i] = __builtin_nontemporal_load(p + (size_t)(2 * i) * t.N);
}
__device__ __forceinline__ void tr_finish(const TrItem& t, int lane, const float (&v)[32], LAS float* scr) {
  const int nblk = t.N / 32, kb = t.item / nblk, nb = t.item % nblk, k0 = 64 * kb, n0 = 32 * nb;
#pragma unroll
  for (int i = 0; i < 32; ++i) scr[(2 * i + (lane >> 5)) * 33 + (lane & 31)] = v[i];
  asm volatile("s_waitcnt lgkmcnt(0)" ::: "memory");
  const int c = lane & 7;
#pragma unroll
  for (int j = 0; j < 4; ++j) { const int n = (lane >> 3) + 8 * j; const LAS float* sp = scr + (8 * c) * 33 + n;
    u32x4 o; o.x = cvt_pk_bf16(sp[0 * 33], sp[1 * 33]); o.y = cvt_pk_bf16(sp[2 * 33], sp[3 * 33]); o.z = cvt_pk_bf16(sp[4 * 33], sp[5 * 33]); o.w = cvt_pk_bf16(sp[6 * 33], sp[7 * 33]);
    *(u32x4*)(t.WT + (size_t)(n0 + n) * t.ldt + t.koff + k0 + 8 * c) = o; }
  asm volatile("s_waitcnt lgkmcnt(0)" ::: "memory");
}

constexpr int I_IN = (DM / 64) * (NIN / 32), I_A = (1024 / 64) * (DM / 32), I_C = (512 / 64) * (DM / 32), I_O = (DM / 64) * (DM / 32);
constexpr int I_L = I_IN + 2 * I_A + I_C + I_O;
#define PH_LOCALS \
  const int tid = opaque_v(wave_s * 64 + (int)__builtin_amdgcn_mbcnt_hi(~0u, __builtin_amdgcn_mbcnt_lo(~0u, 0u))), wave = tid >> 6, lane = tid & 63; \
  const int G = opaque_si((int)gridDim.x), cu = opaque_si((int)blockIdx.x); \
  const int gw = cu * 8 + wave, NGW = G * 8; \
  unsigned char* ws = a.ws + (size_t)(unsigned)opaque_si(0);     \
  bf16_t* WinT = (bf16_t*)(ws + WS_WIN); bf16_t* WbrT = (bf16_t*)(ws + WS_WBR); bf16_t* WoutT = (bf16_t*)(ws + WS_WOUT); \
  bf16_t* H = (bf16_t*)(ws + WS_H); bf16_t* PROJ = (bf16_t*)(ws + WS_PROJ); bf16_t* Y = (bf16_t*)(ws + WS_Y); \
  bf16_t* QBc = (bf16_t*)(ws + WS_QB); bf16_t* KBc = (bf16_t*)(ws + WS_KB); bf16_t* VBc = (bf16_t*)(ws + WS_VB); \
  bf16_t* OC = (bf16_t*)(ws + WS_OC); float* LSE = (float*)(ws + WS_LSE); bf16_t* MRG = (bf16_t*)(ws + WS_MRG); float* OUTF = (float*)(ws + WS_OUT); \
  const float* x_in = a.in[0]; const float* pre_g = a.in[1]; const float* w_in = a.in[2]; const float* b_gate = a.in[3]; \
  const float* qn_g = a.in[4]; const float* kn_g = a.in[5]; const float* rpb = a.in[6]; \
  const float* w_a = a.in[7]; const float* w_b = a.in[8]; const float* w_c = a.in[9]; const float* w_out = a.in[10]; const float* post_g = a.in[11]; \
  float* X = a.out;
__global__ void __launch_bounds__(512) mega(Args a) {
  extern __shared__ __attribute__((aligned(16))) char shm[];
  LAS unsigned char* lds = (LAS unsigned char*)shm;
  cg::grid_group grid = cg::this_grid();
  volatile LAS unsigned* xst = (volatile LAS unsigned*)(lds + 128 * 1024);
  if (threadIdx.x == 0) { xst[0] = 0u; xst[1] = 0u; xst[2] = 0u; xst[3] = 0u; }
  __syncthreads();
  const XcdBarrier xb = xcd_barrier_post((unsigned*)(a.ws + WS_BAR), xst);
  if (a.ph_hi - a.ph_lo > 1) grid.sync();
  const int wave_s = __builtin_amdgcn_readfirstlane((int)threadIdx.x >> 6);

  if ((PHMASK & 1) && a.ph_lo == 0) {
      PH_LOCALS
      LAS float* scr = (LAS float*)(lds + wave * 16384);
      for (int m = gw; m < MT; m += NGW) {
        const f32x4* xr = (const f32x4*)(x_in + (size_t)m * DM) + lane; f32x4* xo = (f32x4*)(X + (size_t)m * DM) + lane;
        f32x4 v[8], gg[8]; float s = 0.f;
#pragma unroll
        for (int j = 0; j < 8; ++j) { v[j] = __builtin_nontemporal_load(xr + 64 * j); gg[j] = ((const f32x4*)pre_g)[64 * j + lane]; }
#pragma unroll
        for (int j = 0; j < 8; ++j) { xo[64 * j] = v[j]; s += (v[j].x * v[j].x + v[j].y * v[j].y) + (v[j].z * v[j].z + v[j].w * v[j].w); }
        const float r = rsqrtf(wave_sum(s) * (1.f / DM) + EPS);
        u32x2* ho = (u32x2*)(H + (size_t)m * DM) + lane;
#pragma unroll
        for (int j = 0; j < 8; ++j) { const f32x4 g = gg[j]; u32x2 w; w.x = cvt_pk_bf16(v[j].x * r * g.x, v[j].y * r * g.y); w.y = cvt_pk_bf16(v[j].z * r * g.z, v[j].w * r * g.w); ho[64 * j] = w; }
      }
  }
  for (int ph = a.ph_lo; ph < a.ph_hi; ++ph) {
    if (ph > a.ph_lo) xcd_barrier(xb);
    {
      const int sub0 = ph > 0 ? (ph - 1) % 6 : -1, lyr = ph > 0 ? (ph - 1) / 6 + 1 : 0;
      const int Gs = opaque_si((int)gridDim.x), cus = opaque_si((int)blockIdx.x);
      const int nwg_in = (MT / 256) * (NIN / 256), rem = nwg_in % Gs;
      const bool all = (ph == 0), part = (sub0 == 0 && lyr < DEPTH && rem > 0 && cus >= rem);
      if ((PHMASK & 1) && (all || part)) {
        PH_LOCALS
        LAS float* scr = (LAS float*)(lds + wave * 16384);
        const int gwi = all ? gw : (cu - rem) * 8 + wave, nwi = all ? NGW : (G - rem) * 8;
#define TR_DEC(IT, T) TrItem T; { const int l_ = lyr; int r_ = (IT) - lyr * I_L; \
          if (r_ < I_IN) { T.W = w_in + (size_t)l_ * DM * NIN; T.WT = WinT + (size_t)l_ * NIN * DM; T.N = NIN; T.ldt = DM; T.koff = 0; } \
          else if ((r_ -= I_IN) < I_A) { T.W = w_a + (size_t)l_ * 1024 * DM; T.WT = WbrT + (size_t)l_ * DM * YW; T.N = DM; T.ldt = YW; T.koff = 0; } \
          else if ((r_ -= I_A) < I_A) { T.W = w_b + (size_t)l_ * 1024 * DM; T.WT = WbrT + (size_t)l_ * DM * YW; T.N = DM; T.ldt = YW; T.koff = 1024; } \
          else if ((r_ -= I_A) < I_C) { T.W = w_c + (size_t)l_ * 512 * DM; T.WT = WbrT + (size_t)l_ * DM * YW; T.N = DM; T.ldt = YW; T.koff = 2048; } \
          else { r_ -= I_C; T.W = w_out + (size_t)l_ * DM * DM; T.WT = WoutT + (size_t)l_ * DM * DM; T.N = DM; T.ldt = DM; T.koff = 0; } \
          T.item = r_; }
        const int it_end = (lyr + 1) * I_L;
        for (int it = lyr * I_L + gwi; it < it_end; it += 2 * nwi) {
          const bool h1 = it + nwi < it_end;
          float v0[32], v1[32];
          TR_DEC(it, T0) TR_DEC(h1 ? it + nwi : it, T1)
          tr_load(T0, lane, v0); tr_load(T1, lane, v1);
          tr_finish(T0, lane, v0, scr);
          if (h1) tr_finish(T1, lane, v1, scr);
        }
#undef TR_DEC
        __syncthreads();
      }
    }
    const int nrep = (PROBE_SUB == 6 ? ph == 0 : (ph > 0 && (ph - 1) % 6 == PROBE_SUB)) ? 2 : 1;
    for (int rep = 0; rep < nrep; ++rep) {
    if (rep) xcd_barrier(xb);
    if (ph == 0) {
    } else {
    const int l = (ph - 1) / 6, sub = (ph - 1) % 6;
    if ((PHMASK & 2) && sub == 0) {
      PH_LOCALS
      pg8::Gemm g{H, WinT + (size_t)l * NIN * DM, MT, NIN, DM, DM, DM};
      pg8::StaticOrder S; S.init(MT, NIN, G, cu);
      pg8::EpiProj E{PROJ, b_gate + (size_t)l * 3 * DM, (u32x4*)(ws + WS_GF)};
      pg8::gemm_phase<pg8::EpiProj, pg8::StaticOrder>(lds, g, S, E, tid);
    } else if ((PHMASK & 4) && sub == 1) {
      PH_LOCALS
      if (P2MASK & 1) {
        const int sb = lane >> 4, u = lane & 15;
        auto prep_item = [&](const int it, const u32x4 raw) {
          const int tok = it / 3, quad = it % 3, hh = quad * 4 + sb, b = tok >> 13, s = tok & (SEQ - 1);
          float xv[8];
#pragma unroll
          for (int q = 0; q < 4; ++q) { xv[2 * q] = bf_lo(raw[q]); xv[2 * q + 1] = bf_hi(raw[q]); }
          u32x4 ov = raw;
          if (hh < 10) {
            float ss = 0.f;
#pragma unroll
            for (int j = 0; j < 8; ++j) ss += xv[j] * xv[j];
            ss += __shfl_xor(ss, 1); ss += __shfl_xor(ss, 2); ss += __shfl_xor(ss, 4); ss += __shfl_xor(ss, 8);
            const float rn = rsqrtf(ss * (1.f / 128.f) + EPS);
            const float* gp = (hh < 8 ? qn_g : kn_g) + l * 128 + u * 8;
            const float pos = (float)((u < 8) ? (s >> 6) : (s & 63));
            const bool upper = (u & 4) != 0;
            float yv[8];
#pragma unroll
            for (int j = 0; j < 8; ++j) {
              const float y = xv[j] * rn * gp[j];
              const float p = __shfl_xor(y, 4);
              const int fi = (u & 3) * 8 + j;
              const float rev = pos * __builtin_amdgcn_exp2f(-0.41524101186092029f * (float)fi) * 0.15915494309189535f;
              const float cs = __builtin_amdgcn_cosf(rev), sn = __builtin_amdgcn_sinf(rev);
              yv[j] = upper ? (p * sn + y * cs) : (y * cs - p * sn);
            }
#pragma unroll
            for (int q = 0; q < 4; ++q) ov[q] = cvt_pk_bf16(yv[2 * q], yv[2 * q + 1]);
          }
          bf16_t* dst = hh < 8 ? QBc + ((size_t)(b * 8 + hh) * SEQ + s) * 128 : (hh < 10 ? KBc + ((size_t)(b * 2 + hh - 8) * SEQ + s) * 128 : VBc + ((size_t)(b * 2 + hh - 10) * SEQ + s) * 128);
          *(u32x4*)(dst + u * 8) = ov;
        };
        auto prep_src = [&](const int it) { const int tok = it / 3, hh = (it % 3) * 4 + sb; return (const u32x4*)(PROJ + (size_t)tok * NIN + C_QB + hh * 128 + u * 8); };
        int it0 = gw;
        for (; it0 + 3 * NGW < MT * 3; it0 += 4 * NGW) {
          const u32x4 r0 = *prep_src(it0), r1 = *prep_src(it0 + NGW), r2 = *prep_src(it0 + 2 * NGW), r3 = *prep_src(it0 + 3 * NGW);
          prep_item(it0, r0); prep_item(it0 + NGW, r1); prep_item(it0 + 2 * NGW, r2); prep_item(it0 + 3 * NGW, r3);
        }
        for (; it0 < MT * 3; it0 += NGW) prep_item(it0, *prep_src(it0));
      }
      if (P2MASK & 2) for (int un = cu; un < NB * 8 * 32; un += G) {
        const int qb = un & 31, h = (un >> 5) & 7, b = un >> 8;
        const int r0 = qb * 4, kr0 = min(max(r0 - 4, 0), 120), krl = min(max(r0 + 3 - 4, 0), 120) + 7;
        __syncthreads();
        if (tid < 465) ((float*)(shm + att::SHM_TBL))[tid] = rpb[(size_t)(l * 8 + h) * 465 + tid] * att::ISCALE;
        att::Unit U{};
        const size_t tq = (size_t)b * SEQ + r0 * 64, tk = (size_t)b * SEQ + kr0 * 64;
        U.Q = PROJ + tq * NIN + C_QA + h * 128; U.K = PROJ + tk * NIN + C_KA + h * 128; U.V = PROJ + tk * NIN + C_VA + h * 128;
        U.ldq = NIN; U.ldk = NIN; U.NT = krl - kr0 + 1;
        U.O = Y + tq * YW + h * 128; U.ldo = YW; U.Z = PROJ + tq * NIN + C_ZA + h * 128; U.ldz = NIN;
        U.qr = r0; U.kr0 = kr0;
        att::attn_body<1, NA_SD, NA_SIMPLE>(U, shm, opaque_v(tid));
      }
      if (P2MASK & 4) for (int un = cu; un < 3 * NB * 4 * 32; un += G) {
        const int qbi = un & 31, hg = (un >> 5) & 3, b = (un >> 7) & 1, g = un >> 8;
        const int dil = g == 0 ? 1 : (g == 1 ? 4 : 16), L = SEQ / dil, npc = L / 256, c = qbi / npc, i0 = (qbi % npc) * 256;
        const int k0 = max(i0 - 64, 0), kend = min(i0 + 320, L), head = g * 4 + hg;
        __syncthreads();
        att::Unit U{};
        const size_t tq = (size_t)b * SEQ + (size_t)i0 * dil + c, tk = (size_t)b * SEQ + (size_t)k0 * dil + c;
        U.Q = PROJ + tq * NIN + C_QC + head * 128; U.K = PROJ + tk * NIN + C_KC + head * 128; U.V = PROJ + tk * NIN + C_VC + head * 128;
        U.ldq = NIN * dil; U.ldk = NIN * dil; U.NT = (kend - k0) >> 6;
        U.O = OC + ((size_t)g * MT + tq) * 512 + hg * 128; U.ldo = 512 * dil;
        U.LSE = LSE + ((size_t)g * MT + tq) * 4 + hg; U.ldl = 4 * dil;
        U.i0 = i0; U.k0 = k0; U.slope = exp2f(-8.f * (float)(head + 1) / 12.f) * (float)dil * att::ISCALE;
        att::attn_body<2, DIL_SD, DIL_SIMPLE>(U, shm, opaque_v(tid));
      }
    } else if ((PHMASK & 8) && sub == 2) {
      PH_LOCALS
      {
        const int hg = lane >> 4, e8 = (lane & 15) * 8;
        struct MixIn { float l0, l1, l2; u32x4 o0, o1, o2, z; };
        auto mix_load = [&](const int tok) { MixIn m;
          m.l0 = LSE[((size_t)0 * MT + tok) * 4 + hg]; m.l1 = LSE[((size_t)1 * MT + tok) * 4 + hg]; m.l2 = LSE[((size_t)2 * MT + tok) * 4 + hg];
          m.o0 = __builtin_nontemporal_load((const u32x4*)(OC + ((size_t)0 * MT + tok) * 512 + hg * 128 + e8)); m.o1 = __builtin_nontemporal_load((const u32x4*)(OC + ((size_t)1 * MT + tok) * 512 + hg * 128 + e8));
          m.o2 = __builtin_nontemporal_load((const u32x4*)(OC + ((size_t)2 * MT + tok) * 512 + hg * 128 + e8)); m.z = *(const u32x4*)(PROJ + (size_t)tok * NIN + C_ZC + hg * 128 + e8); return m; };
        auto mix_item = [&](const int tok, const MixIn& m) {
          const float mx = fmaxf(m.l0, fmaxf(m.l1, m.l2)), e0 = __expf(m.l0 - mx), e1 = __expf(m.l1 - mx), e2 = __expf(m.l2 - mx), inv = 1.f / (e0 + e1 + e2);
          const float w0 = e0 * inv, w1 = e1 * inv, w2 = e2 * inv;
          u32x4 w;
#pragma unroll
          for (int q = 0; q < 4; ++q) { const float lo = (w0 * bf_lo(m.o0[q]) + w1 * bf_lo(m.o1[q]) + w2 * bf_lo(m.o2[q])) * bf_lo(m.z[q]), hi_ = (w0 * bf_hi(m.o0[q]) + w1 * bf_hi(m.o1[q]) + w2 * bf_hi(m.o2[q])) * bf_hi(m.z[q]); w[q] = cvt_pk_bf16(lo, hi_); }
          *(u32x4*)(Y + (size_t)tok * YW + 2048 + hg * 128 + e8) = w; };
        int tok0 = gw;
        for (; tok0 + 3 * NGW < MT; tok0 += 4 * NGW) {
          const MixIn m0 = mix_load(tok0), m1 = mix_load(tok0 + NGW), m2 = mix_load(tok0 + 2 * NGW), m3 = mix_load(tok0 + 3 * NGW);
          mix_item(tok0, m0); mix_item(tok0 + NGW, m1); mix_item(tok0 + 2 * NGW, m2); mix_item(tok0 + 3 * NGW, m3);
        }
        for (; tok0 < MT; tok0 += NGW) mix_item(tok0, mix_load(tok0));
      }
      for (int i = 0;; ++i) {
        const int un = i * G + cu; if (un >= NB * 8 * 32) break;
        const int h = un & 7, qb = (un >> 3) & 31, b = un >> 8;
        __syncthreads();
        att::Unit U{};
        const size_t tq = (size_t)b * SEQ + qb * 256;
        U.Q = QBc + ((size_t)(b * 8 + h) * SEQ + qb * 256) * 128; U.K = KBc + (size_t)(b * 2 + (h >> 2)) * SEQ * 128; U.V = VBc + (size_t)(b * 2 + (h >> 2)) * SEQ * 128;
        U.ldq = 128; U.ldk = 128; U.NT = SEQ / 64;
        U.O = Y + tq * YW + 1024 + h * 128; U.ldo = YW; U.Z = PROJ + tq * NIN + C_ZB + h * 128; U.ldz = NIN;
        att::attn_body<0, 2, false>(U, shm, opaque_v(tid));
      }
    } else if ((PHMASK & 16) && sub == 3) {
      PH_LOCALS
      pg8::Gemm g{Y, WbrT + (size_t)l * DM * YW, MT, DM, YW, YW, YW};
      pg8::StaticOrder S; S.init(MT, DM, G, cu);
      pg8::EpiMerged E{(const u32x4*)(ws + WS_GF), MRG};
      pg8::gemm_phase<pg8::EpiMerged, pg8::StaticOrder>(lds, g, S, E, tid);
    } else if ((PHMASK & 32) && sub == 4) {
      PH_LOCALS
      pg8::Gemm g{MRG, WoutT + (size_t)l * DM * DM, MT, DM, DM, DM, DM};
      pg8::StaticOrder S; S.init(MT, DM, G, cu);
      pg8::EpiF32 E{(bf16_t*)OUTF, DM};
      pg8::gemm_phase<pg8::EpiF32, pg8::StaticOrder>(lds, g, S, E, tid);
    } else if (PHMASK & 64) {
      PH_LOCALS
      f32x4 gpost[8], gpre[8];
#pragma unroll
      for (int j = 0; j < 8; ++j) { const int e4 = 128 * (j >> 1) + 2 * lane + (j & 1);
        gpost[j] = ((const f32x4*)(post_g + (size_t)l * DM))[e4];
        gpre[j] = ((const f32x4*)(pre_g + (size_t)(l + 1 < DEPTH ? l + 1 : l) * DM))[e4]; }
      for (int m0 = gw; m0 < MT; m0 += 2 * NGW) {
        f32x4 v[2][8], xv[2][8];
#pragma unroll
        for (int h = 0; h < 2; ++h) { const size_t m = (size_t)m0 + (size_t)h * NGW; const u32x4* orow = (const u32x4*)((const bf16_t*)OUTF + m * DM) + lane; const f32x4* xi = (const f32x4*)(X + m * DM) + 2 * lane;
#pragma unroll
          for (int jj = 0; jj < 4; ++jj) { const u32x4 w = __builtin_nontemporal_load(orow + 64 * jj);
            v[h][2 * jj] = (f32x4){bf_lo(w.x), bf_hi(w.x), bf_lo(w.y), bf_hi(w.y)}; v[h][2 * jj + 1] = (f32x4){bf_lo(w.z), bf_hi(w.z), bf_lo(w.w), bf_hi(w.w)};
            xv[h][2 * jj] = __builtin_nontemporal_load(xi + 128 * jj); xv[h][2 * jj + 1] = __builtin_nontemporal_load(xi + 128 * jj + 1); } }
#pragma unroll
        for (int h = 0; h < 2; ++h) { const size_t m = (size_t)m0 + (size_t)h * NGW; f32x4* xo = (f32x4*)(X + m * DM) + 2 * lane;
          float s = 0.f;
#pragma unroll
          for (int j = 0; j < 8; ++j) s += (v[h][j].x * v[h][j].x + v[h][j].y * v[h][j].y) + (v[h][j].z * v[h][j].z + v[h][j].w * v[h][j].w);
          const float r = rsqrtf(wave_sum(s) * (1.f / DM) + EPS);
          float s2 = 0.f;
#pragma unroll
          for (int j = 0; j < 8; ++j) { const int e4 = 128 * (j >> 1) + 2 * lane + (j & 1);
            const f32x4 g = gpost[j]; (void)e4;
            v[h][j] = xv[h][j] + v[h][j] * r * g; xo[128 * (j >> 1) + (j & 1)] = v[h][j]; s2 += (v[h][j].x * v[h][j].x + v[h][j].y * v[h][j].y) + (v[h][j].z * v[h][j].z + v[h][j].w * v[h][j].w); }
          if (l + 1 < DEPTH) {
            const float r2 = rsqrtf(wave_sum(s2) * (1.f / DM) + EPS);
            u32x4* ho = (u32x4*)(H + m * DM) + lane;
#pragma unroll
            for (int jj = 0; jj < 4; ++jj) { const f32x4 g0 = gpre[2 * jj], g1 = gpre[2 * jj + 1];
              const f32x4 a0 = v[h][2 * jj], a1 = v[h][2 * jj + 1]; u32x4 w;
              w.x = cvt_pk_bf16(a0.x * r2 * g0.x, a0.y * r2 * g0.y); w.y = cvt_pk_bf16(a0.z * r2 * g0.z, a0.w * r2 * g0.w);
              w.z = cvt_pk_bf16(a1.x * r2 * g1.x, a1.y * r2 * g1.y); w.w = cvt_pk_bf16(a1.z * r2 * g1.z, a1.w * r2 * g1.w); ho[64 * jj] = w; }
          }
        }
      }
    }
    }
    }
  }
}

extern "C" void kernel_launch(void* const* d_in, const int* in_sizes, int n_in, void* d_out, int out_size, void* d_ws, size_t ws_size, hipStream_t stream) {
  static int grid = 0;
  if (grid == 0) {
    if (n_in != 12 || in_sizes[0] != MT * DM || out_size != MT * DM || ws_size < WS_END) {
      fprintf(stderr, "kernel_launch: shape mismatch n_in %d in0 %d out %d ws %zu (need %zu)\n", n_in, n_in > 0 ? in_sizes[0] : -1, out_size, ws_size, (size_t)WS_END); grid = -1; return; }
    int dev = 0, cus = 0, per_cu = 0;
    hipGetDevice(&dev); hipDeviceGetAttribute(&cus, hipDeviceAttributeMultiprocessorCount, dev);
    if (hipFuncSetAttribute((const void*)mega, hipFuncAttributeMaxDynamicSharedMemorySize, LDS_BYTES) != hipSuccess) { fprintf(stderr, "kernel_launch: hipFuncSetAttribute failed\n"); grid = -1; return; }
    if (hipOccupancyMaxActiveBlocksPerMultiprocessor(&per_cu, (const void*)mega, 512, LDS_BYTES) != hipSuccess || per_cu < 1) { fprintf(stderr, "kernel_launch: occupancy query gave %d\n", per_cu); per_cu = 1; }
    (void)hipGetLastError();
    if (cus < 256) { fprintf(stderr, "kernel_launch: built for a 256-CU device, found %d CUs\n", cus); grid = -1; return; }
    grid = 256;
    fprintf(stderr, "kernel_launch: cus %d per_cu %d grid %d\n", cus, per_cu, grid);
  }
  if (grid < 0) return;
  if (hipMemsetAsync((char*)d_ws + WS_BAR, 0, 16384, stream) != hipSuccess) { fprintf(stderr, "kernel_launch: memset of the barrier words failed\n"); return; }
  Args a{};
  for (int i = 0; i < 12; ++i) a.in[i] = (const float*)d_in[i];
  a.out = (float*)d_out; a.ws = (unsigned char*)d_ws;
#if MK_ONE_LAUNCH
  a.ph_lo = 0; a.ph_hi = NPHASE;
  void* args[] = {&a};
  hipError_t e = hipLaunchCooperativeKernel((const void*)mega, dim3(grid), dim3(512), args, LDS_BYTES, stream);
  if (e != hipSuccess) fprintf(stderr, "kernel_launch: cooperative launch failed: %s (grid %d)\n", hipGetErrorString(e), grid);
#else
  for (int ph = 0; ph < NPHASE; ++ph) {
    a.ph_lo = ph; a.ph_hi = ph + 1;
    hipLaunchKernelGGL(mega, dim3(grid), dim3(512), LDS_BYTES, stream, a);
  }
#endif
}
```

```cpp
#include <hip/hip_runtime.h>
#include <hip/hip_cooperative_groups.h>
#include <cstdio>
#include <cstdint>
namespace cg = cooperative_groups;

#ifndef PHMASK
#define PHMASK 0xff
#endif
#ifndef P2MASK
#define P2MASK 7
#endif
#ifndef PROBE_SUB
#define PROBE_SUB -1
#endif
#ifndef NA_SD
#define NA_SD 1
#endif
#ifndef NA_SIMPLE
#define NA_SIMPLE true
#endif
#ifndef DIL_SD
#define DIL_SD 1
#endif
#ifndef DIL_SIMPLE
#define DIL_SIMPLE true
#endif
#ifndef MK_ONE_LAUNCH
#define MK_ONE_LAUNCH 1
#endif

#define LAS __attribute__((address_space(3)))
typedef unsigned short bf16_t;
typedef short bf16x8 __attribute__((ext_vector_type(8)));
typedef short s16x4 __attribute__((ext_vector_type(4)));
typedef float f32x4 __attribute__((ext_vector_type(4)));
typedef float f32x16 __attribute__((ext_vector_type(16)));
typedef unsigned u32x4 __attribute__((ext_vector_type(4)));
typedef unsigned u32x2 __attribute__((ext_vector_type(2)));

constexpr int NB = 2, SEQ = 8192, MT = NB * SEQ, DM = 2048, NIN = 17920, DEPTH = 4, YW = 2560;
constexpr int C_QA = 0, C_KA = 1024, C_VA = 2048, C_QB = 3072, C_QC = 4608, C_KC = 6144, C_VC = 7680, C_ZA = 9216, C_ZB = 10240, C_ZC = 11264, C_G = 11776;
constexpr float EPS = 1e-6f;
constexpr size_t al256(size_t x) { return (x + 255) / 256 * 256; }
constexpr size_t WS_WIN = 0;
constexpr size_t WS_WBR = WS_WIN + al256((size_t)DEPTH * NIN * DM * 2);
constexpr size_t WS_WOUT = WS_WBR + al256((size_t)DEPTH * DM * YW * 2);
constexpr size_t WS_H = WS_WOUT + al256((size_t)DEPTH * DM * DM * 2);
constexpr size_t WS_PROJ = WS_H + al256((size_t)MT * DM * 2);
constexpr size_t WS_Y = WS_PROJ + al256((size_t)MT * NIN * 2);
constexpr size_t WS_QB = WS_Y + al256((size_t)MT * YW * 2);
constexpr size_t WS_KB = WS_QB + al256((size_t)MT * 1024 * 2);
constexpr size_t WS_VB = WS_KB + al256((size_t)MT * 256 * 2);
constexpr size_t WS_OC = WS_VB + al256((size_t)MT * 256 * 2);
constexpr size_t WS_LSE = WS_OC + al256((size_t)3 * MT * 512 * 2);
constexpr size_t WS_MRG = WS_LSE + al256((size_t)3 * MT * 4 * 4);
constexpr size_t WS_OUT = WS_MRG + al256((size_t)MT * DM * 2);
constexpr size_t WS_GF = WS_OUT + al256((size_t)MT * DM * 4);
constexpr size_t WS_BAR = WS_GF + al256((size_t)3 * MT * DM * 2);
constexpr size_t WS_END = WS_BAR + 16384;

typedef __bf16 bf16x2_t __attribute__((ext_vector_type(2)));
typedef float f32x2_t __attribute__((ext_vector_type(2)));
__device__ __forceinline__ unsigned cvt_pk_bf16(float lo, float hi) { f32x2_t v = {lo, hi}; bf16x2_t r = __builtin_convertvector(v, bf16x2_t); return __builtin_bit_cast(unsigned, r); }
__device__ __forceinline__ float bf_lo(unsigned w) { return __uint_as_float(w << 16); }
__device__ __forceinline__ float bf_hi(unsigned w) { return __uint_as_float(w & 0xffff0000u); }
__device__ __forceinline__ float bf2f(bf16_t v) { return __uint_as_float(((unsigned)v) << 16); }
__device__ __forceinline__ int opaque_v(int v) { asm volatile("" : "+v"(v)); return v; }
__device__ __forceinline__ int opaque_si(int v) { asm volatile("" : "+s"(v)); return v; }
template <class T> __device__ __forceinline__ T* opaque_s(T* p) { asm volatile("" : "+s"(p)); return p; }
__device__ __forceinline__ float sigmoidf_(float v) { return __builtin_amdgcn_rcpf(1.0f + __builtin_amdgcn_exp2f(-1.4426950408889634f * v)); }

namespace pg8 {
constexpr int BM = 256, BK = 64, HALF = 128, HTB = HALF * BK * 2, STAGE_BYTES = 8 * HTB, NXCD = 8, WGM = 8;
__host__ __device__ __forceinline__ int lds_byte(int r, int c) { const int st = (r >> 4) * 2 + (c >> 5), rr = r & 15, cc = c & 31, ob = rr * 64 + cc * 2; return st * 1024 + (ob ^ (((ob >> 9) & 1) << 5)); }
__host__ __device__ __forceinline__ void stage_rc(int b, int& R, int& C) { const int st = b / 1024, sb = b % 1024, swz = sb ^ (((sb >> 9) & 1) << 5); R = (st >> 1) * 16 + swz / 64; C = (st & 1) * 32 + (swz % 64) / 2; }
__host__ __device__ __forceinline__ int perm32(int rho) { const int n = rho >> 4, i = rho & 15; return 8 * (i >> 2) + 4 * n + (i & 3); }
struct Unit { int pm, pn; };
struct Gemm { const bf16_t* A; const bf16_t* Bt; int M, N, K, lda, ldb; };
struct StaticOrder {
    int nM, nN, nwg, G, c;
    __device__ void init(int M, int N, int G_, int c_) { nM = M / BM; nN = N / BM; nwg = nM * nN; G = G_; c = c_; }
    __device__ bool next(int i, Unit& u) const {
        const long L = (long)i * G + c; if (L >= nwg) return false;
        int wgid = (int)L; { const int q = nwg / NXCD, r = nwg % NXCD, xcd = wgid % NXCD, off = wgid / NXCD; wgid = (xcd < r ? xcd * (q + 1) : r * (q + 1) + (xcd - r) * q) + off; }
        const int nig = WGM * nN, gid = wgid / nig, fm = gid * WGM, gsz = (nM - fm) < WGM ? (nM - fm) : WGM;
        u.pm = fm + ((wgid % nig) % gsz); u.pn = (wgid % nig) / gsz; return true;
    }
};
struct EpiProj {
    static constexpr bool PERM = true, HAS_MID = false;
    bf16_t* O; const LAS float* bgate; u32x4* GF;
    __device__ __forceinline__ void mid(f32x4 (&)[2][2][4][2], const Unit&, int, int, int, int, int) const {}
    __device__ __forceinline__ void operator()(const f32x4 (&acc)[2][2][4][2], const Unit& u, int wr, int wc, int fr, int fq) const {
        fr = opaque_v(fr); fq = opaque_v(fq);
        const int row0 = u.pm * BM + wr * 64 + fr, colt = u.pn * BM, col0 = colt + wc * 32 + 8 * fq;
        const int mode = colt < C_ZA ? 0 : (colt < C_G ? 1 : 2);
        if (mode == 2) {
            const int gt = u.pn - C_G / BM;
            u32x4* gf = GF + ((size_t)(((gt >> 3) * 64 + u.pm) * 8 + (gt & 7)) * 8 + (wr * 4 + wc)) * 1024 + fq * 16 + fr;
            f32x4 bv[2][2];
#pragma unroll
            for (int bj = 0; bj < 2; ++bj)
#pragma unroll
                for (int n = 0; n < 2; ++n) bv[bj][n] = *(const LAS f32x4*)(bgate + (col0 - C_G) + bj * HALF + 4 * n);
#pragma unroll
            for (int ai = 0; ai < 2; ++ai)
#pragma unroll
                for (int m = 0; m < 4; ++m)
#pragma unroll
                    for (int bj = 0; bj < 2; ++bj) { const f32x4 v0 = acc[ai][bj][m][0] + bv[bj][0], v1 = acc[ai][bj][m][1] + bv[bj][1];
                        u32x4 w; w.x = cvt_pk_bf16(sigmoidf_(v0[0]), sigmoidf_(v0[1])); w.y = cvt_pk_bf16(sigmoidf_(v0[2]), sigmoidf_(v0[3]));
                        w.z = cvt_pk_bf16(sigmoidf_(v1[0]), sigmoidf_(v1[1])); w.w = cvt_pk_bf16(sigmoidf_(v1[2]), sigmoidf_(v1[3]));
                        gf[((ai * 4 + m) * 2 + bj) * 64] = w; }
            return;
        }
#pragma unroll
        for (int ai = 0; ai < 2; ++ai)
#pragma unroll
            for (int m = 0; m < 4; ++m) { bf16_t* rowp = O + (size_t)(row0 + ai * HALF + m * 16) * NIN + col0;
#pragma unroll
                for (int bj = 0; bj < 2; ++bj) { f32x4 v0 = acc[ai][bj][m][0], v1 = acc[ai][bj][m][1];
                    if (mode != 0) {
#pragma unroll
                        for (int j = 0; j < 4; ++j) { v0[j] *= sigmoidf_(v0[j]); v1[j] *= sigmoidf_(v1[j]); }
                    }
                    u32x4 w; w.x = cvt_pk_bf16(v0[0], v0[1]); w.y = cvt_pk_bf16(v0[2], v0[3]); w.z = cvt_pk_bf16(v1[0], v1[1]); w.w = cvt_pk_bf16(v1[2], v1[3]);
                    *(u32x4*)(rowp + bj * HALF) = w; } }
    }
};
struct EpiMerged {
    static constexpr bool PERM = true, HAS_MID = true;
    const u32x4* GF;
    bf16_t* O;
    __device__ __forceinline__ const u32x4* gbase(int gate, const Unit& u, int wr, int wc, int fr, int fq) const {
        return GF + ((size_t)((gate * 64 + u.pm) * 8 + u.pn) * 8 + (wr * 4 + wc)) * 1024 + fq * 16 + fr; }
    __device__ __forceinline__ void mid(f32x4 (&acc)[2][2][4][2], const Unit& u, int t, int wr, int wc, int fr, int fq) const {
        fr = opaque_v(fr); fq = opaque_v(fq);
        const int gn = (t == 16) ? 0 : 1;
        const u32x4* pa = gbase(gn, u, wr, wc, fr, fq); const u32x4* pb = gbase(gn + 1, u, wr, wc, fr, fq);
        u32x4 a0[4], b0[4], a1[4], b1[4];
#define GF_LD(A, B, H) _Pragma("unroll") for (int k = 0; k < 4; ++k) { A[k] = pa[((H) * 4 + k) * 64]; B[k] = pb[((H) * 4 + k) * 64]; }
#define GF_USE(A, B, H) _Pragma("unroll") for (int k = 0; k < 4; ++k) { const int f = (H) * 4 + k, ai = f >> 3, m = (f >> 1) & 3, bj = f & 1; \
            _Pragma("unroll") for (int q = 0; q < 4; ++q) { const float r0 = bf_lo(A[k][q]) * __builtin_amdgcn_rcpf(fmaxf(bf_lo(B[k][q]), 1e-30f)), r1 = bf_hi(A[k][q]) * __builtin_amdgcn_rcpf(fmaxf(bf_hi(B[k][q]), 1e-30f)); \
                acc[ai][bj][m][q >> 1][(q & 1) * 2] *= r0; acc[ai][bj][m][q >> 1][(q & 1) * 2 + 1] *= r1; } }
        GF_LD(a0, b0, 0) GF_LD(a1, b1, 1)
        asm volatile("" ::: "memory");
        GF_USE(a0, b0, 0) GF_LD(a0, b0, 2)
        asm volatile("" ::: "memory");
        GF_USE(a1, b1, 1) GF_LD(a1, b1, 3)
        asm volatile("" ::: "memory");
        GF_USE(a0, b0, 2)
        GF_USE(a1, b1, 3)
#undef GF_LD
#undef GF_USE
    }
    __device__ __forceinline__ void operator()(const f32x4 (&acc)[2][2][4][2], const Unit& u, int wr, int wc, int fr, int fq) const {
        fr = opaque_v(fr); fq = opaque_v(fq);
        const int row0 = u.pm * BM + wr * 64 + fr, col0 = u.pn * BM + wc * 32 + 8 * fq;
        const u32x4* pc = gbase(2, u, wr, wc, fr, fq);
#pragma unroll
        for (int h = 0; h < 2; ++h) {
            u32x4 c[8];
#pragma unroll
            for (int k = 0; k < 8; ++k) c[k] = pc[(h * 8 + k) * 64];
            asm volatile("" ::: "memory");
#pragma unroll
            for (int k = 0; k < 8; ++k) { const int f = h * 8 + k, ai = f >> 3, m = (f >> 1) & 3, bj = f & 1;
                bf16_t* rowp = O + (size_t)(row0 + ai * HALF + m * 16) * DM + col0; const f32x4 v0 = acc[ai][bj][m][0], v1 = acc[ai][bj][m][1];
                u32x4 w; w.x = cvt_pk_bf16(v0[0] * bf_lo(c[k].x), v0[1] * bf_hi(c[k].x)); w.y = cvt_pk_bf16(v0[2] * bf_lo(c[k].y), v0[3] * bf_hi(c[k].y));
                w.z = cvt_pk_bf16(v1[0] * bf_lo(c[k].z), v1[1] * bf_hi(c[k].z)); w.w = cvt_pk_bf16(v1[2] * bf_lo(c[k].w), v1[3] * bf_hi(c[k].w));
                *(u32x4*)(rowp + bj * HALF) = w; }
        }
    }
};
struct EpiF32 {
    static constexpr bool PERM = true, HAS_MID = false;
    bf16_t* O; int ldc;
    __device__ __forceinline__ void mid(f32x4 (&)[2][2][4][2], const Unit&, int, int, int, int, int) const {}
    __device__ __forceinline__ void operator()(const f32x4 (&acc)[2][2][4][2], const Unit& u, int wr, int wc, int fr, int fq) const {
        fr = opaque_v(fr); fq = opaque_v(fq);
        const int row0 = u.pm * BM + wr * 64 + fr, col0 = u.pn * BM + wc * 32 + 8 * fq;
#pragma unroll
        for (int ai = 0; ai < 2; ++ai)
#pragma unroll
            for (int m = 0; m < 4; ++m) { bf16_t* rowp = O + (size_t)(row0 + ai * HALF + m * 16) * ldc + col0;
#pragma unroll
                for (int bj = 0; bj < 2; ++bj) { const f32x4 v0 = acc[ai][bj][m][0], v1 = acc[ai][bj][m][1];
                    u32x4 w; w.x = cvt_pk_bf16(v0[0], v0[1]); w.y = cvt_pk_bf16(v0[2], v0[3]); w.z = cvt_pk_bf16(v1[0], v1[1]); w.w = cvt_pk_bf16(v1[2], v1[3]);
                    *(u32x4*)(rowp + bj * HALF) = w; } }
    }
};

template <class Epi, class Sched>
__device__ __forceinline__ void gemm_phase(LAS unsigned char* lds, const Gemm g, const Sched& S, const Epi& E, const int tid) {
    const int wid = __builtin_amdgcn_readfirstlane(tid >> 6), lane = tid & 63, wr = wid >> 2, wc = wid & 3, fr = lane & 15, fq = lane >> 4;
    const int K = g.K, nt = K / BK;
    unsigned voffA[2], voffB[2];
#pragma unroll
    for (int i = 0; i < 2; ++i) { int R, C; stage_rc(tid * 16 + i * 8192, R, C); const int Rb = Epi::PERM ? ((R & ~31) + perm32(R & 31)) : R;
        voffA[i] = (unsigned)(R * g.lda + C) * 2u; voffB[i] = (unsigned)(Rb * g.ldb + C) * 2u; }
    const size_t kstep = (size_t)(BK * 2);
    const size_t hstepA = (size_t)HALF * g.lda * 2, hstepB = (size_t)HALF * g.ldb * 2;
    const size_t tstepA = 2 * hstepA, tstepB = 2 * hstepB;
    const unsigned ldsw = (unsigned)wid * 1024u;
    const int aoff = lds_byte(wr * 64 + fr, fq * 8), boff = lds_byte(wc * 32 + fr, fq * 8);
#define PG8_SA(b, h) (((b) * 2 + (h)) * HTB)
#define PG8_SB(b, h) ((4 + (b) * 2 + (h)) * HTB)
#define PG8_STAGE(bufoff, gbase, voff) do { _Pragma("unroll") for (int _i = 0; _i < 2; ++_i) \
        __builtin_amdgcn_global_load_lds((const unsigned*)((const char*)(gbase) + (voff)[_i]), (LAS unsigned*)(lds + (bufoff) + ldsw + _i * 8192), 16, 0, 0); } while (0)
#define PG8_LDA(dst, b, h) do { _Pragma("unroll") for (int m = 0; m < 4; ++m) _Pragma("unroll") for (int k = 0; k < 2; ++k) dst[m][k] = *(const LAS bf16x8*)(lds + PG8_SA(b, h) + aoff + m * 2048 + k * 1024); } while (0)
#define PG8_LDB(dst, b, h) do { _Pragma("unroll") for (int n = 0; n < 2; ++n) _Pragma("unroll") for (int k = 0; k < 2; ++k) dst[n][k] = *(const LAS bf16x8*)(lds + PG8_SB(b, h) + boff + n * 2048 + k * 1024); } while (0)
#define PG8_MMA(ai, bj, At, Bt) do { __builtin_amdgcn_s_setprio(1); _Pragma("unroll") for (int m = 0; m < 4; ++m) _Pragma("unroll") for (int n = 0; n < 2; ++n) _Pragma("unroll") for (int k = 0; k < 2; ++k) \
        acc[ai][bj][m][n] = __builtin_amdgcn_mfma_f32_16x16x32_bf16(Bt[n][k], At[m][k], acc[ai][bj][m][n], 0, 0, 0); __builtin_amdgcn_s_setprio(0); } while (0)
#define PG8_WAIT_V(n) asm volatile("s_waitcnt vmcnt(" #n ")" ::: "memory")
#define PG8_WAIT_L(n) asm volatile("s_waitcnt lgkmcnt(" #n ")" ::: "memory")
#define PG8_BAR __builtin_amdgcn_s_barrier()
#define PG8_SCHED __builtin_amdgcn_sched_barrier(0)
    Unit cur, nxt; int ui = 0;
    if (!S.next(0, cur)) return;
    f32x4 acc[2][2][4][2];
#pragma unroll
    for (int a = 0; a < 2; ++a)
#pragma unroll
        for (int b = 0; b < 2; ++b)
#pragma unroll
            for (int m = 0; m < 4; ++m)
#pragma unroll
                for (int n = 0; n < 2; ++n) acc[a][b][m][n] = (f32x4){0.f, 0.f, 0.f, 0.f};
    bf16x8 At[4][2], B0[2][2], B1[2][2];
    const char* cA = (const char*)g.A + (size_t)cur.pm * tstepA; const char* cB = (const char*)g.Bt + (size_t)cur.pn * tstepB;
    PG8_STAGE(PG8_SB(0, 0), cB, voffB); PG8_STAGE(PG8_SB(0, 1), cB + hstepB, voffB); PG8_STAGE(PG8_SA(0, 0), cA, voffA); PG8_STAGE(PG8_SA(0, 1), cA + hstepA, voffA);
    if (wr == 1) PG8_BAR;
    PG8_WAIT_V(2); PG8_BAR;
    PG8_STAGE(PG8_SB(1, 0), cB + kstep, voffB); PG8_STAGE(PG8_SA(1, 0), cA + kstep, voffA); PG8_STAGE(PG8_SB(1, 1), cB + hstepB + kstep, voffB);
    PG8_WAIT_V(6); PG8_BAR;
    for (;;) {
        const bool has_next = S.next(ui + 1, nxt);
        const char* nA = has_next ? (const char*)g.A + (size_t)nxt.pm * tstepA : cA; const char* nB = has_next ? (const char*)g.Bt + (size_t)nxt.pn * tstepB : cB;
        for (int t = 0; t < nt; t += 2) {
            const bool last = (t == nt - 2);
            const char* a1 = cA + (size_t)(t + 1) * kstep;
            const char* a2 = last ? nA : cA + (size_t)(t + 2) * kstep; const char* b2 = last ? nB : cB + (size_t)(t + 2) * kstep;
            const char* a3 = a2 + kstep; const char* b3 = b2 + kstep;
            if constexpr (Epi::HAS_MID) { if (t == 16 || t == 32) E.mid(acc, cur, t, wr, wc, fr, fq); }
            PG8_LDB(B0, 0, 0); PG8_LDB(B1, 0, 1); PG8_SCHED; PG8_LDA(At, 0, 0); PG8_STAGE(PG8_SA(1, 1), a1 + hstepA, voffA);
            PG8_WAIT_V(8); PG8_WAIT_L(0); PG8_BAR; PG8_MMA(0, 0, At, B0); PG8_MMA(0, 1, At, B1); PG8_BAR; PG8_SCHED;
            PG8_LDA(At, 0, 1); PG8_STAGE(PG8_SB(0, 0), b2, voffB); PG8_STAGE(PG8_SB(0, 1), b2 + hstepB, voffB); PG8_STAGE(PG8_SA(0, 0), a2, voffA);
            PG8_WAIT_V(8); PG8_WAIT_L(0); PG8_BAR; PG8_MMA(1, 0, At, B0); PG8_MMA(1, 1, At, B1); PG8_BAR; PG8_SCHED;
            PG8_LDB(B0, 1, 0); PG8_LDB(B1, 1, 1); PG8_SCHED; PG8_LDA(At, 1, 0); PG8_STAGE(PG8_SA(0, 1), a2 + hstepA, voffA);
            PG8_WAIT_V(8); PG8_WAIT_L(0); PG8_BAR; PG8_MMA(0, 0, At, B0); PG8_MMA(0, 1, At, B1); PG8_BAR; PG8_SCHED;
            PG8_LDA(At, 1, 1); PG8_STAGE(PG8_SB(1, 0), b3, voffB); PG8_STAGE(PG8_SB(1, 1), b3 + hstepB, voffB); PG8_STAGE(PG8_SA(1, 0), a3, voffA);
            PG8_WAIT_V(8); PG8_WAIT_L(0); PG8_BAR; PG8_MMA(1, 0, At, B0); PG8_MMA(1, 1, At, B1); PG8_BAR; PG8_SCHED;
        }
        if (wr == 0) PG8_BAR;
        E(acc, cur, wr, wc, fr, fq);
        if (!has_next) break;
#pragma unroll
        for (int a = 0; a < 2; ++a)
#pragma unroll
            for (int b = 0; b < 2; ++b)
#pragma unroll
                for (int m = 0; m < 4; ++m)
#pragma unroll
                    for (int n = 0; n < 2; ++n) acc[a][b][m][n] = (f32x4){0.f, 0.f, 0.f, 0.f};
        cur = nxt; cA = nA; cB = nB; ++ui;
        if (wr == 1) PG8_BAR;
    }
    PG8_WAIT_V(0);
    PG8_BAR;
#undef PG8_SA
#undef PG8_SB
#undef PG8_STAGE
#undef PG8_LDA
#undef PG8_LDB
#undef PG8_MMA
#undef PG8_WAIT_V
#undef PG8_WAIT_L
#undef PG8_BAR
#undef PG8_SCHED
}
}

namespace att {
constexpr int D = 128, NW = 8, QBLK = 32, KVBLK = 64;
constexpr float SCALE = 0.088388347648318440f, ISCALE = 11.313708498984761f;
constexpr float THR = 8.f, NEG = -30000.f;
constexpr size_t SHM_V = KVBLK * D * 2, SHM_K = KVBLK * D * 2, SHM_WS = 71680  , SHM_TBL = SHM_WS + NW * 64 * 4 + 256, SHM_ATTN = SHM_TBL + 2560;
#define KSWZ(row, colB) ((row) * 256 + ((colB) ^ (((row) & 7) << 4)))
#define SBAR() __builtin_amdgcn_sched_barrier(0)
__device__ __forceinline__ int crow(int r, int hi) { return (r & 3) + 8 * (r >> 2) + 4 * hi; }
__device__ __forceinline__ void partialSM(f32x16& p0, f32x16& p1, float& m_reg, float& mn, float& alpha) {
  constexpr float C = SCALE * 1.4426950408889634f;
  float pmax = p0[0];
#pragma unroll
  for (int r = 1; r < 16; ++r) pmax = fmaxf(pmax, p0[r]);
#pragma unroll
  for (int r = 0; r < 16; ++r) pmax = fmaxf(pmax, p1[r]);
  { auto rr = __builtin_amdgcn_permlane32_swap(__float_as_uint(pmax), __float_as_uint(pmax), false, false);
    pmax = fmaxf(__uint_as_float(rr[0]), __uint_as_float(rr[1])); }
  if (__builtin_expect(__all(pmax - m_reg <= THR / SCALE), 1)) { mn = m_reg; alpha = 1.f; }
  else { mn = fmaxf(m_reg, pmax); alpha = __builtin_amdgcn_exp2f((m_reg - mn) * C); m_reg = mn; }
  float mnC = -mn * C;
#pragma unroll
  for (int r = 0; r < 16; ++r) p0[r] = fmaf(p0[r], C, mnC);
#pragma unroll
  for (int r = 0; r < 16; ++r) p1[r] = fmaf(p1[r], C, mnC);
#pragma unroll
  for (int r = 0; r < 16; ++r) p0[r] = __builtin_amdgcn_exp2f(p0[r]);
}
__device__ __forceinline__ void finishSM(f32x16& p0, f32x16& p1, float alpha, float& l_reg, bf16x8& pa0, bf16x8& pa1, bf16x8& pa2, bf16x8& pa3) {
#pragma unroll
  for (int r = 0; r < 16; ++r) p1[r] = __builtin_amdgcn_exp2f(p1[r]);
  float ps = 0;
#pragma unroll
  for (int r = 0; r < 16; ++r) ps += p0[r];
#pragma unroll
  for (int r = 0; r < 16; ++r) ps += p1[r];
  { auto rr = __builtin_amdgcn_permlane32_swap(__float_as_uint(ps), __float_as_uint(ps), false, false);
    ps = __uint_as_float(rr[0]) + __uint_as_float(rr[1]); }
  l_reg = l_reg * alpha + ps;
#define PK4(P, BASE, OUT) do { unsigned a0 = cvt_pk_bf16(P[BASE + 0], P[BASE + 1]), a1 = cvt_pk_bf16(P[BASE + 2], P[BASE + 3]);   \
    unsigned b0 = cvt_pk_bf16(P[BASE + 4], P[BASE + 5]), b1 = cvt_pk_bf16(P[BASE + 6], P[BASE + 7]);                              \
    auto r0 = __builtin_amdgcn_permlane32_swap(a0, b0, false, false); auto r1 = __builtin_amdgcn_permlane32_swap(a1, b1, false, false); \
    u32x4 w = {r0[0], r1[0], r0[1], r1[1]}; OUT = *reinterpret_cast<bf16x8*>(&w); } while (0)
  PK4(p0, 0, pa0); PK4(p0, 8, pa1); PK4(p1, 0, pa2); PK4(p1, 8, pa3);
#undef PK4
}
__device__ __forceinline__ void qkt(f32x16& p0, f32x16& p1, const char* Ks, const bf16x8* qr, int r32, int hi) {
  p0 = f32x16{}; p1 = f32x16{};
#pragma unroll
  for (int d0 = 0; d0 < 8; ++d0) { int cb = (d0 * 16 + hi * 8) * 2;
    bf16x8 b0 = *reinterpret_cast<const bf16x8*>(Ks + KSWZ(r32, cb));
    bf16x8 b1 = *reinterpret_cast<const bf16x8*>(Ks + KSWZ(32 + r32, cb));
    p0 = __builtin_amdgcn_mfma_f32_32x32x16_bf16(b0, qr[d0], p0, 0, 0, 0);
    p1 = __builtin_amdgcn_mfma_f32_32x32x16_bf16(b1, qr[d0], p1, 0, 0, 0); }
}
__device__ __forceinline__ int v_st(int k, int c) { const int kk = (k & ~0xC) | ((k & 4) << 1) | ((k & 8) >> 1); return ((kk >> 3) * 4 + (c >> 5)) * 512 + ((kk & 7) * 32 + (c & 31)) * 2; }
__device__ __forceinline__ int v_rd_base(int lane) { return ((lane & 3) << 3) | (((lane >> 2) & 3) << 6) | (((lane >> 4) & 1) << 5) | (((lane >> 5) & 1) << 8); }
constexpr int v_rd_off(int d0, int ks, int half) { return d0 * 512 + ks * 4096 + half * 2048; }
template <int OFF> __device__ __forceinline__ s16x4 tr_read(int vb) {
  s16x4 r; asm volatile("ds_read_b64_tr_b16 %0, %1 offset:%2" : "=&v"(r) : "v"(vb), "i"(OFF) : "memory"); return r;
}
template <int D0> __device__ __forceinline__ void pv_one(f32x16& od, int vb, bf16x8 pa0, bf16x8 pa1, bf16x8 pa2, bf16x8 pa3) {
  const s16x4 l0 = tr_read<v_rd_off(D0, 0, 0)>(vb), h0 = tr_read<v_rd_off(D0, 0, 1)>(vb), l1 = tr_read<v_rd_off(D0, 1, 0)>(vb), h1 = tr_read<v_rd_off(D0, 1, 1)>(vb);
  const s16x4 l2 = tr_read<v_rd_off(D0, 2, 0)>(vb), h2 = tr_read<v_rd_off(D0, 2, 1)>(vb), l3 = tr_read<v_rd_off(D0, 3, 0)>(vb), h3 = tr_read<v_rd_off(D0, 3, 1)>(vb);
  asm volatile("s_waitcnt lgkmcnt(0)" ::: "memory"); SBAR();
#define PK(L, H) (bf16x8){L[0], L[1], L[2], L[3], H[0], H[1], H[2], H[3]}
  od = __builtin_amdgcn_mfma_f32_32x32x16_bf16(pa0, PK(l0, h0), od, 0, 0, 0);
  od = __builtin_amdgcn_mfma_f32_32x32x16_bf16(pa1, PK(l1, h1), od, 0, 0, 0);
  od = __builtin_amdgcn_mfma_f32_32x32x16_bf16(pa2, PK(l2, h2), od, 0, 0, 0);
  od = __builtin_amdgcn_mfma_f32_32x32x16_bf16(pa3, PK(l3, h3), od, 0, 0, 0);
#undef PK
}
__device__ __forceinline__ void pv_d0(f32x16* o, int vb, bf16x8 pa0, bf16x8 pa1, bf16x8 pa2, bf16x8 pa3) {
  pv_one<0>(o[0], vb, pa0, pa1, pa2, pa3); pv_one<1>(o[1], vb, pa0, pa1, pa2, pa3); pv_one<2>(o[2], vb, pa0, pa1, pa2, pa3); pv_one<3>(o[3], vb, pa0, pa1, pa2, pa3);
}

struct Unit {
  const bf16_t* Q; const bf16_t* K; const bf16_t* V;
  int ldq, ldk;
  int NT;
  bf16_t* O; int ldo;
  const bf16_t* Z; int ldz;
  float* LSE; int ldl;
  int qr, kr0;
  int i0, k0; float slope;
};

template <int MODE>
__device__ __forceinline__ void amask(f32x16& p0, f32x16& p1, int j, const Unit& U, int wid, int r32, int hi, const float* tbl) {
  if constexpr (MODE == 1) {
    const int qrow = U.qr + (wid >> 1), kr = U.kr0 + j, st = min(max(qrow - 4, 0), 120);
    if (kr < st || kr >= st + 8) {
#pragma unroll
      for (int r = 0; r < 16; ++r) { p0[r] = NEG; p1[r] = NEG; }
    } else {
      const int jq = (wid & 1) * 32 + r32, cs = min(max(jq - 8, 0), 48);
      const float* tr = tbl + (kr - qrow + 7) * 31 + (15 - jq);
#pragma unroll
      for (int r2 = 0; r2 < 8; ++r2) {
        float b0[2], b1[2];
#pragma unroll
        for (int q = 0; q < 2; ++q) { const int c = crow(r2 * 2 + q, hi); b0[q] = tr[c]; b1[q] = tr[c + 32]; }
        asm volatile("" ::: "memory");
#pragma unroll
        for (int q = 0; q < 2; ++q) { const int r = r2 * 2 + q, c = crow(r, hi);
          p0[r] = ((unsigned)(c - cs) < 16u) ? p0[r] + b0[q] : NEG;
          p1[r] = ((unsigned)(c + 32 - cs) < 16u) ? p1[r] + b1[q] : NEG; }
      }
    }
  } else if constexpr (MODE == 2) {
    const int base = U.k0 + j * 64 - (U.i0 + wid * 32 + r32);
#pragma unroll
    for (int r = 0; r < 16; ++r) { const int c = crow(r, hi); const int d0 = abs(base + c), d1 = abs(base + c + 32);
      p0[r] = (d0 <= 64) ? p0[r] - U.slope * (float)d0 : NEG;
      p1[r] = (d1 <= 64) ? p1[r] - U.slope * (float)d1 : NEG; }
  }
}

template <int MODE, int SDEPTH, bool SIMPLE>
__device__ __forceinline__ void attn_body(const Unit& U, char* lds, const int tid) {
  const int wid = tid >> 6, lane = tid & 63, r32 = lane & 31, hi = lane >> 5;
  char* V_lds = lds; char* K_lds = lds + 2 * SHM_V;
  float* ws = (float*)(lds + SHM_WS) + wid * 64; float* li_l = ws; float* al_l = ws + 32;
  const float* tbl = (const float*)(lds + SHM_TBL);
  float m_reg = -1e30f, l_reg = 0; f32x16 o[4] = {}; bf16x8 qr[8];
  const bf16_t* Qw = U.Q + (long)(wid * QBLK + r32) * U.ldq + hi * 8;
#pragma unroll
  for (int d0 = 0; d0 < 8; ++d0) qr[d0] = *reinterpret_cast<const bf16x8*>(Qw + d0 * 16);
  const int sr = tid >> 4, sc = (tid & 15) * 8, vst0 = v_st(sr, sc), vst1 = v_st(32 + sr, sc);
  const int vb0 = (int)(uintptr_t)V_lds + v_rd_base(lane);
  const bf16_t* Kh = U.K; const bf16_t* Vh = U.V; const int LDK = U.ldk;
  struct { bf16x8 vs0, vs1, ks0, ks1; } sr_[SDEPTH];
#define SLOAD(i, k0) do { sr_[i].vs0 = *(const bf16x8*)(&Vh[(long)((k0) + sr) * LDK + sc]); sr_[i].vs1 = *(const bf16x8*)(&Vh[(long)((k0) + 32 + sr) * LDK + sc]); \
    sr_[i].ks0 = *(const bf16x8*)(&Kh[(long)((k0) + sr) * LDK + sc]); sr_[i].ks1 = *(const bf16x8*)(&Kh[(long)((k0) + 32 + sr) * LDK + sc]); } while (0)
#define SWRITE(b, i) do { *(bf16x8*)(V_lds + (b) * SHM_V + vst0) = sr_[i].vs0;          \
    *(bf16x8*)(V_lds + (b) * SHM_V + vst1) = sr_[i].vs1; int kc = sc * 2;               \
    *(bf16x8*)(K_lds + (b) * SHM_K + KSWZ(sr, kc)) = sr_[i].ks0;                       \
    *(bf16x8*)(K_lds + (b) * SHM_K + KSWZ(32 + sr, kc)) = sr_[i].ks1; } while (0)
#define SWAIT() do { if constexpr (SDEPTH == 2) asm volatile("s_waitcnt vmcnt(4)" ::: "memory"); else asm volatile("s_waitcnt vmcnt(0)" ::: "memory"); } while (0)
#define RESC(a) do { if (__any((a) < 1.f)) { if (hi == 0) al_l[r32] = (a); asm volatile("s_waitcnt lgkmcnt(0)" ::: "memory"); \
    _Pragma("unroll") for (int d = 0; d < 4; ++d) _Pragma("unroll") for (int r = 0; r < 16; ++r) o[d][r] *= al_l[crow(r, hi)]; } } while (0)
  bf16x8 pa0, pa1, pa2, pa3; const int NT = U.NT;
  if constexpr (SIMPLE) {
    f32x16 p0, p1; float mn, al;
    SLOAD(0, 0);
    for (int j = 0; j < NT; ++j) {
      asm volatile("s_waitcnt vmcnt(0)" ::: "memory"); __syncthreads(); SWRITE(0, 0);
      if (j + 1 < NT) SLOAD(0, (j + 1) * KVBLK);
      __syncthreads();
      bool act = true;
      if constexpr (MODE == 1) { const int qrow = U.qr + (wid >> 1), kr = U.kr0 + j, st = min(max(qrow - 4, 0), 120); act = (kr >= st) && (kr < st + 8); }
      if constexpr (MODE == 2) { const int q0 = U.i0 + wid * 32, t0 = U.k0 + j * 64; act = (t0 + 63 >= q0 - 64) && (t0 <= q0 + 31 + 64); }
      if (act) {
        qkt(p0, p1, K_lds, qr, r32, hi); amask<MODE>(p0, p1, j, U, wid, r32, hi, tbl);
        partialSM(p0, p1, m_reg, mn, al); finishSM(p0, p1, al, l_reg, pa0, pa1, pa2, pa3);
        RESC(al); SBAR();
        pv_d0(o, vb0, pa0, pa1, pa2, pa3);
      }
    }
  } else {
  f32x16 pA0, pA1, pB0, pB1; float mnA, mnB, alA, alB;
  constexpr int SE = 0, SO = SDEPTH - 1;
  SLOAD(SE, 0); asm volatile("s_waitcnt vmcnt(0)" ::: "memory"); SWRITE(0, SE); __syncthreads();
  qkt(pA0, pA1, K_lds, qr, r32, hi); amask<MODE>(pA0, pA1, 0, U, wid, r32, hi, tbl); partialSM(pA0, pA1, m_reg, mnA, alA);
  SLOAD(SO, KVBLK); if constexpr (SDEPTH == 2) { if (2 < NT) SLOAD(SE, 2 * KVBLK); }
  SWAIT(); SWRITE(1, SO); __syncthreads();
  for (int j = 1; j + 1 < NT; j += 2) {
    SBAR(); qkt(pB0, pB1, K_lds + SHM_K, qr, r32, hi); amask<MODE>(pB0, pB1, j, U, wid, r32, hi, tbl);
    finishSM(pA0, pA1, alA, l_reg, pa0, pa1, pa2, pa3); SBAR();
    SLOAD(SO, (j + SDEPTH) * KVBLK); SBAR();
    pv_d0(o, vb0, pa0, pa1, pa2, pa3); partialSM(pB0, pB1, m_reg, mnB, alB);
    __syncthreads(); SWAIT(); SWRITE(0, SE);
    RESC(alB); __syncthreads();
    SBAR(); qkt(pA0, pA1, K_lds, qr, r32, hi); amask<MODE>(pA0, pA1, j + 1, U, wid, r32, hi, tbl);
    finishSM(pB0, pB1, alB, l_reg, pa0, pa1, pa2, pa3); SBAR();
    if (SDEPTH == 1 || j + 3 < NT) SLOAD(SE, (j + 1 + SDEPTH) * KVBLK); SBAR();
    pv_d0(o, vb0 + (int)SHM_V, pa0, pa1, pa2, pa3); partialSM(pA0, pA1, m_reg, mnA, alA);
    __syncthreads(); SWAIT(); SWRITE(1, SO);
    RESC(alA); __syncthreads();
  }
  SBAR(); qkt(pB0, pB1, K_lds + SHM_K, qr, r32, hi); amask<MODE>(pB0, pB1, NT - 1, U, wid, r32, hi, tbl);
  finishSM(pA0, pA1, alA, l_reg, pa0, pa1, pa2, pa3); SBAR();
  pv_d0(o, vb0, pa0, pa1, pa2, pa3); partialSM(pB0, pB1, m_reg, mnB, alB);
  __syncthreads(); RESC(alB);
  finishSM(pB0, pB1, alB, l_reg, pa0, pa1, pa2, pa3); SBAR();
  pv_d0(o, vb0 + (int)SHM_V, pa0, pa1, pa2, pa3);
  }
  if (hi == 0) li_l[r32] = l_reg; asm volatile("s_waitcnt lgkmcnt(0)" ::: "memory");
  if constexpr (MODE == 2) { if (hi == 0) U.LSE[(long)(wid * QBLK + r32) * U.ldl] = m_reg * SCALE + __logf(l_reg); }
  __syncthreads();
  constexpr int OP = 136;
  bf16_t* ol = (bf16_t*)lds + wid * (32 * OP);
#pragma unroll
  for (int r = 0; r < 16; ++r) { const float rl = __builtin_amdgcn_rcpf(li_l[crow(r, hi)]); bf16_t* op = ol + crow(r, hi) * OP + r32;
#pragma unroll
    for (int d0 = 0; d0 < 4; ++d0) op[d0 * 32] = (bf16_t)(cvt_pk_bf16(o[d0][r] * rl, 0.f) & 0xffffu); }
  asm volatile("s_waitcnt lgkmcnt(0)" ::: "memory");
  { const int cc = (lane & 15) * 8, rb = lane >> 4;
    u32x4 zz[8];
    if constexpr (MODE != 2) {
#pragma unroll
      for (int i = 0; i < 8; ++i) zz[i] = *(const u32x4*)(U.Z + (long)(wid * QBLK + rb + 4 * i) * U.ldz + cc);
    }
#pragma unroll
    for (int i = 0; i < 8; ++i) { const int row = rb + 4 * i; const long orow = wid * QBLK + row;
      u32x4 v = *(const u32x4*)(ol + row * OP + cc);
      if constexpr (MODE != 2) { const u32x4 z = zz[i];
#pragma unroll
        for (int q = 0; q < 4; ++q) v[q] = cvt_pk_bf16(bf_lo(v[q]) * bf_lo(z[q]), bf_hi(v[q]) * bf_hi(z[q])); }
      *(u32x4*)(U.O + orow * U.ldo + cc) = v; } }
#undef SLOAD
#undef SWRITE
#undef SWAIT
#undef RESC
}
}

#define XB_TMO      128
#define XB_XCNT(j)  (256  + 64 * (j))
#define XB_XSUB(j)  (1280 + 64 * (j))
#define XB_XGEN(j)  (2304 + 64 * (j))
#define XB_TOP      3328
#define XB_TOPGEN   3392
#define XCD_BAR_WORDS 3456
#define XB_SPIN_CAP (1u << 18)

__device__ __forceinline__ unsigned xb_ld(unsigned* p)              { return __hip_atomic_load(p, __ATOMIC_RELAXED, __HIP_MEMORY_SCOPE_AGENT); }
__device__ __forceinline__ unsigned xb_add(unsigned* p, unsigned v) { return __hip_atomic_fetch_add(p, v, __ATOMIC_RELAXED, __HIP_MEMORY_SCOPE_AGENT); }
__device__ __forceinline__ unsigned xb_xcc_id() { return (unsigned)__builtin_amdgcn_s_getreg((3 << 11) | 20) & 0xFu; }
#define XB_SPIN(cond, bar) do { unsigned _sp = 0; while (cond) { __builtin_amdgcn_s_sleep(1); \
    if ((++_sp & 255u) == 0u) { if (xb_ld(&(bar)[XB_TMO])) break; if (_sp > XB_SPIN_CAP) { atomicAdd(&(bar)[XB_TMO], 1u); break; } } } } while (0)

struct XcdBarrier {
    unsigned* bar; unsigned x;
    volatile LAS unsigned* st;
};

__device__ __forceinline__ XcdBarrier xcd_barrier_post(unsigned* bar, volatile LAS unsigned* st) {
    XcdBarrier b; b.bar = bar; b.x = xb_xcc_id(); b.st = st;
    if (threadIdx.x == 0) (void)xb_add(&bar[XB_XCNT(b.x)], 1u);
    return b;
}
__device__ __forceinline__ void xcd_barrier_complete(unsigned* bar, unsigned x, unsigned& nloc, unsigned& nx) {
    const unsigned G = gridDim.x * gridDim.y * gridDim.z;
    unsigned sum, cnt, mine, sp = 0u;
    for (;;) {
        sum = 0u; cnt = 0u; mine = 0u;
#pragma unroll
        for (unsigned j = 0; j < 16; ++j) { const unsigned c = xb_ld(&bar[XB_XCNT(j)]); sum += c; cnt += (c > 0u) ? 1u : 0u; mine = (j == x) ? c : mine; }
        if (sum == G) break;
        __builtin_amdgcn_s_sleep(1);
        if ((++sp & 255u) == 0u) { if (xb_ld(&bar[XB_TMO])) break; if (sp > XB_SPIN_CAP) { atomicAdd(&bar[XB_TMO], 1u); break; } }
    }
    nloc = mine > 0u ? mine : 1u; nx = cnt > 0u ? cnt : 1u;
}

__device__ __forceinline__ void xcd_barrier(const XcdBarrier& b) {
    asm volatile("s_waitcnt vmcnt(0)" ::: "memory");
    __syncthreads();
    if (threadIdx.x == 0) {
        unsigned* bar = b.bar;
        __builtin_amdgcn_s_waitcnt(0);
        unsigned nloc = b.st[0], nx = b.st[1];
        if (nloc == 0u) { xcd_barrier_complete(bar, b.x, nloc, nx); b.st[0] = nloc; b.st[1] = nx; }
        const unsigned old = xb_add(&bar[XB_XSUB(b.x)], 1u);
        const unsigned gen = old / nloc;
        if (old + 1u == (gen + 1u) * nloc) {
            __builtin_amdgcn_fence(__ATOMIC_RELEASE, "agent");
            asm volatile("s_waitcnt vmcnt(0)" ::: "memory");
            const unsigned og = xb_add(&bar[XB_TOP], 1u);
            const unsigned tg = og / nx;
            if (og + 1u == (tg + 1u) * nx) xb_add(&bar[XB_TOPGEN], 1u);
            else XB_SPIN(xb_ld(&bar[XB_TOPGEN]) == tg, bar);
            __builtin_amdgcn_fence(__ATOMIC_ACQUIRE, "agent");
            xb_add(&bar[XB_XGEN(b.x)], 1u);
            asm volatile("s_waitcnt vmcnt(0)" ::: "memory");
        } else {
            XB_SPIN(xb_ld(&bar[XB_XGEN(b.x)]) == gen, bar);
            __builtin_amdgcn_fence(__ATOMIC_ACQUIRE, "agent");
            asm volatile("s_waitcnt vmcnt(0)" ::: "memory");
        }
    }
    __syncthreads();
}


constexpr int LDS_BIAS = 128 * 1024 + 256;
constexpr int LDS_BYTES = LDS_BIAS + 3 * DM * 4;
static_assert(att::SHM_ATTN <= 128 * 1024 && pg8::STAGE_BYTES <= 128 * 1024 && XCD_BAR_WORDS * 4 <= 16384, "LDS");
struct Args { const float* in[12]; float* out; unsigned char* ws; int ph_lo, ph_hi; };
constexpr int NPHASE = 1 + 6 * DEPTH;

__device__ __forceinline__ float wave_sum(float v) {
#pragma unroll
  for (int o = 1; o < 64; o <<= 1) v += __shfl_xor(v, o);
  return v;
}
struct TrItem { const float* W; bf16_t* WT; int N, ldt, koff, item; };
__device__ __forceinline__ void tr_load(const TrItem& t, int lane, float (&v)[32]) {
  const int nblk = t.N / 32, kb = t.item / nblk, nb = t.item % nblk, k0 = 64 * kb, n0 = 32 * nb;
  const float* p = t.W + (size_t)(k0 + (lane >> 5)) * t.N + n0 + (lane & 31);
#pragma unroll
  for (int i = 0; i < 32; ++i) v[i] = __builtin_nontemporal_load(p + (size_t)(2 * i) * t.N);
}
__device__ __forceinline__ void tr_finish(const TrItem& t, int lane, const float (&v)[32], LAS float* scr) {
  const int nblk = t.N / 32, kb = t.item / nblk, nb = t.item % nblk, k0 = 64 * kb, n0 = 32 * nb;
#pragma unroll
  for (int i = 0; i < 32; ++i) scr[(2 * i + (lane >> 5)) * 33 + (lane & 31)] = v[i];
  asm volatile("s_waitcnt lgkmcnt(0)" ::: "memory");
  const int c = lane & 7;
#pragma unroll
  for (int j = 0; j < 4; ++j) { const int n = (lane >> 3) + 8 * j; const LAS float* sp = scr + (8 * c) * 33 + n;
    u32x4 o; o.x = cvt_pk_bf16(sp[0 * 33], sp[1 * 33]); o.y = cvt_pk_bf16(sp[2 * 33], sp[3 * 33]); o.z = cvt_pk_bf16(sp[4 * 33], sp[5 * 33]); o.w = cvt_pk_bf16(sp[6 * 33], sp[7 * 33]);
    *(u32x4*)(t.WT + (size_t)(n0 + n) * t.ldt + t.koff + k0 + 8 * c) = o; }
  asm volatile("s_waitcnt lgkmcnt(0)" ::: "memory");
}

constexpr int I_IN = (DM / 64) * (NIN / 32), I_A = (1024 / 64) * (DM / 32), I_C = (512 / 64) * (DM / 32), I_O = (DM / 64) * (DM / 32);
constexpr int I_L = I_IN + 2 * I_A + I_C + I_O;
#define PH_LOCALS \
  const int tid = opaque_v(wave_s * 64 + (int)__builtin_amdgcn_mbcnt_hi(~0u, __builtin_amdgcn_mbcnt_lo(~0u, 0u))), wave = tid >> 6, lane = tid & 63; \
  const int G = opaque_si((int)gridDim.x), cu = opaque_si((int)blockIdx.x); \
  const int gw = cu * 8 + wave, NGW = G * 8; \
  unsigned char* ws = a.ws + (size_t)(unsigned)opaque_si(0);     \
  bf16_t* WinT = (bf16_t*)(ws + WS_WIN); bf16_t* WbrT = (bf16_t*)(ws + WS_WBR); bf16_t* WoutT = (bf16_t*)(ws + WS_WOUT); \
  bf16_t* H = (bf16_t*)(ws + WS_H); bf16_t* PROJ = (bf16_t*)(ws + WS_PROJ); bf16_t* Y = (bf16_t*)(ws + WS_Y); \
  bf16_t* QBc = (bf16_t*)(ws + WS_QB); bf16_t* KBc = (bf16_t*)(ws + WS_KB); bf16_t* VBc = (bf16_t*)(ws + WS_VB); \
  bf16_t* OC = (bf16_t*)(ws + WS_OC); float* LSE = (float*)(ws + WS_LSE); bf16_t* MRG = (bf16_t*)(ws + WS_MRG); float* OUTF = (float*)(ws + WS_OUT); \
  const float* x_in = a.in[0]; const float* pre_g = a.in[1]; const float* w_in = a.in[2]; const float* b_gate = a.in[3]; \
  const float* qn_g = a.in[4]; const float* kn_g = a.in[5]; const float* rpb = a.in[6]; \
  const float* w_a = a.in[7]; const float* w_b = a.in[8]; const float* w_c = a.in[9]; const float* w_out = a.in[10]; const float* post_g = a.in[11]; \
  float* X = a.out;
__global__ void __launch_bounds__(512) mega(Args a) {
  extern __shared__ __attribute__((aligned(16))) char shm[];
  LAS unsigned char* lds = (LAS unsigned char*)shm;
  cg::grid_group grid = cg::this_grid();
  volatile LAS unsigned* xst = (volatile LAS unsigned*)(lds + 128 * 1024);
  if (threadIdx.x == 0) { xst[0] = 0u; xst[1] = 0u; xst[2] = 0u; xst[3] = 0u; }
  __syncthreads();
  const XcdBarrier xb = xcd_barrier_post((unsigned*)(a.ws + WS_BAR), xst);
  if (a.ph_hi - a.ph_lo > 1) grid.sync();
  const int wave_s = __builtin_amdgcn_readfirstlane((int)threadIdx.x >> 6);

  if ((PHMASK & 1) && a.ph_lo == 0) {
      PH_LOCALS
      LAS float* scr = (LAS float*)(lds + wave * 16384);
      for (int m = gw; m < MT; m += NGW) {
        const f32x4* xr = (const f32x4*)(x_in + (size_t)m * DM) + lane; f32x4* xo = (f32x4*)(X + (size_t)m * DM) + lane;
        f32x4 v[8], gg[8]; float s = 0.f;
#pragma unroll
        for (int j = 0; j < 8; ++j) { v[j] = __builtin_nontemporal_load(xr + 64 * j); gg[j] = ((const f32x4*)pre_g)[64 * j + lane]; }
#pragma unroll
        for (int j = 0; j < 8; ++j) { xo[64 * j] = v[j]; s += (v[j].x * v[j].x + v[j].y * v[j].y) + (v[j].z * v[j].z + v[j].w * v[j].w); }
        const float r = rsqrtf(wave_sum(s) * (1.f / DM) + EPS);
        u32x2* ho = (u32x2*)(H + (size_t)m * DM) + lane;
#pragma unroll
        for (int j = 0; j < 8; ++j) { const f32x4 g = gg[j]; u32x2 w; w.x = cvt_pk_bf16(v[j].x * r * g.x, v[j].y * r * g.y); w.y = cvt_pk_bf16(v[j].z * r * g.z, v[j].w * r * g.w); ho[64 * j] = w; }
      }
  }
  for (int ph = a.ph_lo; ph < a.ph_hi; ++ph) {
    if (ph > a.ph_lo) xcd_barrier(xb);
    {
      const int sub0 = ph > 0 ? (ph - 1) % 6 : -1, lyr = ph > 0 ? (ph - 1) / 6 + 1 : 0;
      const int Gs = opaque_si((int)gridDim.x), cus = opaque_si((int)blockIdx.x);
      const int nwg_in = (MT / 256) * (NIN / 256), rem = nwg_in % Gs;
      const bool all = (ph == 0), part = (sub0 == 0 && lyr < DEPTH && rem > 0 && cus >= rem);
      if ((PHMASK & 1) && (all || part)) {
        PH_LOCALS
        LAS float* scr = (LAS float*)(lds + wave * 16384);
        const int gwi = all ? gw : (cu - rem) * 8 + wave, nwi = all ? NGW : (G - rem) * 8;
#define TR_DEC(IT, T) TrItem T; { const int l_ = lyr; int r_ = (IT) - lyr * I_L; \
          if (r_ < I_IN) { T.W = w_in + (size_t)l_ * DM * NIN; T.WT = WinT + (size_t)l_ * NIN * DM; T.N = NIN; T.ldt = DM; T.koff = 0; } \
          else if ((r_ -= I_IN) < I_A) { T.W = w_a + (size_t)l_ * 1024 * DM; T.WT = WbrT + (size_t)l_ * DM * YW; T.N = DM; T.ldt = YW; T.koff = 0; } \
          else if ((r_ -= I_A) < I_A) { T.W = w_b + (size_t)l_ * 1024 * DM; T.WT = WbrT + (size_t)l_ * DM * YW; T.N = DM; T.ldt = YW; T.koff = 1024; } \
          else if ((r_ -= I_A) < I_C) { T.W = w_c + (size_t)l_ * 512 * DM; T.WT = WbrT + (size_t)l_ * DM * YW; T.N = DM; T.ldt = YW; T.koff = 2048; } \
          else { r_ -= I_C; T.W = w_out + (size_t)l_ * DM * DM; T.WT = WoutT + (size_t)l_ * DM * DM; T.N = DM; T.ldt = DM; T.koff = 0; } \
          T.item = r_; }
        const int it_end = (lyr + 1) * I_L;
        for (int it = lyr * I_L + gwi; it < it_end; it += 2 * nwi) {
          const bool h1 = it + nwi < it_end;
          float v0[32], v1[32];
          TR_DEC(it, T0) TR_DEC(h1 ? it + nwi : it, T1)
          tr_load(T0, lane, v0); tr_load(T1, lane, v1);
          tr_finish(T0, lane, v0, scr);
          if (h1) tr_finish(T1, lane, v1, scr);
        }
#undef TR_DEC
        __syncthreads();
      }
    }
    const int nrep = (PROBE_SUB == 6 ? ph == 0 : (ph > 0 && (ph - 1) % 6 == PROBE_SUB)) ? 2 : 1;
    for (int rep = 0; rep < nrep; ++rep) {
    if (rep) xcd_barrier(xb);
    if (ph == 0) {
    } else {
    const int l = (ph - 1) / 6, sub = (ph - 1) % 6;
    if ((PHMASK & 2) && sub == 0) {
      PH_LOCALS
      pg8::Gemm g{H, WinT + (size_t)l * NIN * DM, MT, NIN, DM, DM, DM};
      pg8::StaticOrder S; S.init(MT, NIN, G, cu);
      { const f32x4* bg = (const f32x4*)(b_gate + (size_t)l * 3 * DM); LAS f32x4* bl = (LAS f32x4*)(lds + LDS_BIAS);
        for (int i = tid; i < 3 * DM / 4; i += 512) bl[i] = bg[i];
        __syncthreads(); }
      pg8::EpiProj E{PROJ, (const LAS float*)(lds + LDS_BIAS), (u32x4*)(ws + WS_GF)};
      pg8::gemm_phase<pg8::EpiProj, pg8::StaticOrder>(lds, g, S, E, tid);
    } else if ((PHMASK & 4) && sub == 1) {
      PH_LOCALS
      if (P2MASK & 1) {
        const int sb = lane >> 4, u = lane & 15;
        auto prep_item = [&](const int it, const u32x4 raw) {
          const int tok = it / 3, quad = it % 3, hh = quad * 4 + sb, b = tok >> 13, s = tok & (SEQ - 1);
          float xv[8];
#pragma unroll
          for (int q = 0; q < 4; ++q) { xv[2 * q] = bf_lo(raw[q]); xv[2 * q + 1] = bf_hi(raw[q]); }
          u32x4 ov = raw;
          if (hh < 10) {
            float ss = 0.f;
#pragma unroll
            for (int j = 0; j < 8; ++j) ss += xv[j] * xv[j];
            ss += __shfl_xor(ss, 1); ss += __shfl_xor(ss, 2); ss += __shfl_xor(ss, 4); ss += __shfl_xor(ss, 8);
            const float rn = rsqrtf(ss * (1.f / 128.f) + EPS);
            const float* gp = (hh < 8 ? qn_g : kn_g) + l * 128 + u * 8;
            const float pos = (float)((u < 8) ? (s >> 6) : (s & 63));
            const bool upper = (u & 4) != 0;
            float yv[8];
#pragma unroll
            for (int j = 0; j < 8; ++j) {
              const float y = xv[j] * rn * gp[j];
              const float p = __shfl_xor(y, 4);
              const int fi = (u & 3) * 8 + j;
              const float rev = pos * __builtin_amdgcn_exp2f(-0.41524101186092029f * (float)fi) * 0.15915494309189535f;
              const float cs = __builtin_amdgcn_cosf(rev), sn = __builtin_amdgcn_sinf(rev);
              yv[j] = upper ? (p * sn + y * cs) : (y * cs - p * sn);
            }
#pragma unroll
            for (int q = 0; q < 4; ++q) ov[q] = cvt_pk_bf16(yv[2 * q], yv[2 * q + 1]);
          }
          bf16_t* dst = hh < 8 ? QBc + ((size_t)(b * 8 + hh) * SEQ + s) * 128 : (hh < 10 ? KBc + ((size_t)(b * 2 + hh - 8) * SEQ + s) * 128 : VBc + ((size_t)(b * 2 + hh - 10) * SEQ + s) * 128);
          *(u32x4*)(dst + u * 8) = ov;
        };
        auto prep_src = [&](const int it) { const int tok = it / 3, hh = (it % 3) * 4 + sb; return (const u32x4*)(PROJ + (size_t)tok * NIN + C_QB + hh * 128 + u * 8); };
        int it0 = gw;
        for (; it0 + 3 * NGW < MT * 3; it0 += 4 * NGW) {
          const u32x4 r0 = *prep_src(it0), r1 = *prep_src(it0 + NGW), r2 = *prep_src(it0 + 2 * NGW), r3 = *prep_src(it0 + 3 * NGW);
          prep_item(it0, r0); prep_item(it0 + NGW, r1); prep_item(it0 + 2 * NGW, r2); prep_item(it0 + 3 * NGW, r3);
        }
        for (; it0 < MT * 3; it0 += NGW) prep_item(it0, *prep_src(it0));
      }
      if (P2MASK & 2) for (int un = cu; un < NB * 8 * 32; un += G) {
        const int qb = un & 31, h = (un >> 5) & 7, b = un >> 8;
        const int r0 = qb * 4, kr0 = min(max(r0 - 4, 0), 120), krl = min(max(r0 + 3 - 4, 0), 120) + 7;
        __syncthreads();
        if (tid < 465) ((float*)(shm + att::SHM_TBL))[tid] = rpb[(size_t)(l * 8 + h) * 465 + tid] * att::ISCALE;
        att::Unit U{};
        const size_t tq = (size_t)b * SEQ + r0 * 64, tk = (size_t)b * SEQ + kr0 * 64;
        U.Q = PROJ + tq * NIN + C_QA + h * 128; U.K = PROJ + tk * NIN + C_KA + h * 128; U.V = PROJ + tk * NIN + C_VA + h * 128;
        U.ldq = NIN; U.ldk = NIN; U.NT = krl - kr0 + 1;
        U.O = Y + tq * YW + h * 128; U.ldo = YW; U.Z = PROJ + tq * NIN + C_ZA + h * 128; U.ldz = NIN;
        U.qr = r0; U.kr0 = kr0;
        att::attn_body<1, NA_SD, NA_SIMPLE>(U, shm, opaque_v(tid));
      }
      if (P2MASK & 4) for (int un = cu; un < 3 * NB * 4 * 32; un += G) {
        const int qbi = un & 31, hg = (un >> 5) & 3, b = (un >> 7) & 1, g = un >> 8;
        const int dil = g == 0 ? 1 : (g == 1 ? 4 : 16), L = SEQ / dil, npc = L / 256, c = qbi / npc, i0 = (qbi % npc) * 256;
        const int k0 = max(i0 - 64, 0), kend = min(i0 + 320, L), head = g * 4 + hg;
        __syncthreads();
        att::Unit U{};
        const size_t tq = (size_t)b * SEQ + (size_t)i0 * dil + c, tk = (size_t)b * SEQ + (size_t)k0 * dil + c;
        U.Q = PROJ + tq * NIN + C_QC + head * 128; U.K = PROJ + tk * NIN + C_KC + head * 128; U.V = PROJ + tk * NIN + C_VC + head * 128;
        U.ldq = NIN * dil; U.ldk = NIN * dil; U.NT = (kend - k0) >> 6;
        U.O = OC + ((size_t)g * MT + tq) * 512 + hg * 128; U.ldo = 512 * dil;
        U.LSE = LSE + ((size_t)g * MT + tq) * 4 + hg; U.ldl = 4 * dil;
        U.i0 = i0; U.k0 = k0; U.slope = exp2f(-8.f * (float)(head + 1) / 12.f) * (float)dil * att::ISCALE;
        att::attn_body<2, DIL_SD, DIL_SIMPLE>(U, shm, opaque_v(tid));
      }
    } else if ((PHMASK & 8) && sub == 2) {
      PH_LOCALS
      {
        const int hg = lane >> 4, e8 = (lane & 15) * 8;
        struct MixIn { float l0, l1, l2; u32x4 o0, o1, o2, z; };
        auto mix_load = [&](const int tok) { MixIn m;
          m.l0 = LSE[((size_t)0 * MT + tok) * 4 + hg]; m.l1 = LSE[((size_t)1 * MT + tok) * 4 + hg]; m.l2 = LSE[((size_t)2 * MT + tok) * 4 + hg];
          m.o0 = __builtin_nontemporal_load((const u32x4*)(OC + ((size_t)0 * MT + tok) * 512 + hg * 128 + e8)); m.o1 = __builtin_nontemporal_load((const u32x4*)(OC + ((size_t)1 * MT + tok) * 512 + hg * 128 + e8));
          m.o2 = __builtin_nontemporal_load((const u32x4*)(OC + ((size_t)2 * MT + tok) * 512 + hg * 128 + e8)); m.z = *(const u32x4*)(PROJ + (size_t)tok * NIN + C_ZC + hg * 128 + e8); return m; };
        auto mix_item = [&](const int tok, const MixIn& m) {
          const float mx = fmaxf(m.l0, fmaxf(m.l1, m.l2)), e0 = __expf(m.l0 - mx), e1 = __expf(m.l1 - mx), e2 = __expf(m.l2 - mx), inv = 1.f / (e0 + e1 + e2);
          const float w0 = e0 * inv, w1 = e1 * inv, w2 = e2 * inv;
          u32x4 w;
#pragma unroll
          for (int q = 0; q < 4; ++q) { const float lo = (w0 * bf_lo(m.o0[q]) + w1 * bf_lo(m.o1[q]) + w2 * bf_lo(m.o2[q])) * bf_lo(m.z[q]), hi_ = (w0 * bf_hi(m.o0[q]) + w1 * bf_hi(m.o1[q]) + w2 * bf_hi(m.o2[q])) * bf_hi(m.z[q]); w[q] = cvt_pk_bf16(lo, hi_); }
          *(u32x4*)(Y + (size_t)tok * YW + 2048 + hg * 128 + e8) = w; };
        int tok0 = gw;
        for (; tok0 + 3 * NGW < MT; tok0 += 4 * NGW) {
          const MixIn m0 = mix_load(tok0), m1 = mix_load(tok0 + NGW), m2 = mix_load(tok0 + 2 * NGW), m3 = mix_load(tok0 + 3 * NGW);
          mix_item(tok0, m0); mix_item(tok0 + NGW, m1); mix_item(tok0 + 2 * NGW, m2); mix_item(tok0 + 3 * NGW, m3);
        }
        for (; tok0 < MT; tok0 += NGW) mix_item(tok0, mix_load(tok0));
      }
      for (int i = 0;; ++i) {
        const int un = i * G + cu; if (un >= NB * 8 * 32) break;
        const int h = un & 7, qb = (un >> 3) & 31, b = un >> 8;
        __syncthreads();
        att::Unit U{};
        const size_t tq = (size_t)b * SEQ + qb * 256;
        U.Q = QBc + ((size_t)(b * 8 + h) * SEQ + qb * 256) * 128; U.K = KBc + (size_t)(b * 2 + (h >> 2)) * SEQ * 128; U.V = VBc + (size_t)(b * 2 + (h >> 2)) * SEQ * 128;
        U.ldq = 128; U.ldk = 128; U.NT = SEQ / 64;
        U.O = Y + tq * YW + 1024 + h * 128; U.ldo = YW; U.Z = PROJ + tq * NIN + C_ZB + h * 128; U.ldz = NIN;
        att::attn_body<0, 2, false>(U, shm, opaque_v(tid));
      }
    } else if ((PHMASK & 16) && sub == 3) {
      PH_LOCALS
      pg8::Gemm g{Y, WbrT + (size_t)l * DM * YW, MT, DM, YW, YW, YW};
      pg8::StaticOrder S; S.init(MT, DM, G, cu);
      pg8::EpiMerged E{(const u32x4*)(ws + WS_GF), MRG};
      pg8::gemm_phase<pg8::EpiMerged, pg8::StaticOrder>(lds, g, S, E, tid);
    } else if ((PHMASK & 32) && sub == 4) {
      PH_LOCALS
      pg8::Gemm g{MRG, WoutT + (size_t)l * DM * DM, MT, DM, DM, DM, DM};
      pg8::StaticOrder S; S.init(MT, DM, G, cu);
      pg8::EpiF32 E{(bf16_t*)OUTF, DM};
      pg8::gemm_phase<pg8::EpiF32, pg8::StaticOrder>(lds, g, S, E, tid);
    } else if (PHMASK & 64) {
      PH_LOCALS
      f32x4 gpost[8], gpre[8];
#pragma unroll
      for (int j = 0; j < 8; ++j) { const int e4 = 128 * (j >> 1) + 2 * lane + (j & 1);
        gpost[j] = ((const f32x4*)(post_g + (size_t)l * DM))[e4];
        gpre[j] = ((const f32x4*)(pre_g + (size_t)(l + 1 < DEPTH ? l + 1 : l) * DM))[e4]; }
      for (int m0 = gw; m0 < MT; m0 += 2 * NGW) {
        f32x4 v[2][8], xv[2][8];
#pragma unroll
        for (int h = 0; h < 2; ++h) { const size_t m = (size_t)m0 + (size_t)h * NGW; const u32x4* orow = (const u32x4*)((const bf16_t*)OUTF + m * DM) + lane; const f32x4* xi = (const f32x4*)(X + m * DM) + 2 * lane;
#pragma unroll
          for (int jj = 0; jj < 4; ++jj) { const u32x4 w = __builtin_nontemporal_load(orow + 64 * jj);
            v[h][2 * jj] = (f32x4){bf_lo(w.x), bf_hi(w.x), bf_lo(w.y), bf_hi(w.y)}; v[h][2 * jj + 1] = (f32x4){bf_lo(w.z), bf_hi(w.z), bf_lo(w.w), bf_hi(w.w)};
            xv[h][2 * jj] = __builtin_nontemporal_load(xi + 128 * jj); xv[h][2 * jj + 1] = __builtin_nontemporal_load(xi + 128 * jj + 1); } }
#pragma unroll
        for (int h = 0; h < 2; ++h) { const size_t m = (size_t)m0 + (size_t)h * NGW; f32x4* xo = (f32x4*)(X + m * DM) + 2 * lane;
          float s = 0.f;
#pragma unroll
          for (int j = 0; j < 8; ++j) s += (v[h][j].x * v[h][j].x + v[h][j].y * v[h][j].y) + (v[h][j].z * v[h][j].z + v[h][j].w * v[h][j].w);
          const float r = rsqrtf(wave_sum(s) * (1.f / DM) + EPS);
          float s2 = 0.f;
#pragma unroll
          for (int j = 0; j < 8; ++j) { const int e4 = 128 * (j >> 1) + 2 * lane + (j & 1);
            const f32x4 g = gpost[j]; (void)e4;
            v[h][j] = xv[h][j] + v[h][j] * r * g; xo[128 * (j >> 1) + (j & 1)] = v[h][j]; s2 += (v[h][j].x * v[h][j].x + v[h][j].y * v[h][j].y) + (v[h][j].z * v[h][j].z + v[h][j].w * v[h][j].w); }
          if (l + 1 < DEPTH) {
            const float r2 = rsqrtf(wave_sum(s2) * (1.f / DM) + EPS);
            u32x4* ho = (u32x4*)(H + m * DM) + lane;
#pragma unroll
            for (int jj = 0; jj < 4; ++jj) { const f32x4 g0 = gpre[2 * jj], g1 = gpre[2 * jj + 1];
              const f32x4 a0 = v[h][2 * jj], a1 = v[h][2 * jj + 1]; u32x4 w;
              w.x = cvt_pk_bf16(a0.x * r2 * g0.x, a0.y * r2 * g0.y); w.y = cvt_pk_bf16(a0.z * r2 * g0.z, a0.w * r2 * g0.w);
              w.z = cvt_pk_bf16(a1.x * r2 * g1.x, a1.y * r2 * g1.y); w.w = cvt_pk_bf16(a1.z * r2 * g1.z, a1.w * r2 * g1.w); ho[64 * jj] = w; }
          }
        }
      }
    }
    }
    }
  }
}

extern "C" void kernel_launch(void* const* d_in, const int* in_sizes, int n_in, void* d_out, int out_size, void* d_ws, size_t ws_size, hipStream_t stream) {
  static int grid = 0;
  if (grid == 0) {
    if (n_in != 12 || in_sizes[0] != MT * DM || out_size != MT * DM || ws_size < WS_END) {
      fprintf(stderr, "kernel_launch: shape mismatch n_in %d in0 %d out %d ws %zu (need %zu)\n", n_in, n_in > 0 ? in_sizes[0] : -1, out_size, ws_size, (size_t)WS_END); grid = -1; return; }
    int dev = 0, cus = 0, per_cu = 0;
    hipGetDevice(&dev); hipDeviceGetAttribute(&cus, hipDeviceAttributeMultiprocessorCount, dev);
    if (hipFuncSetAttribute((const void*)mega, hipFuncAttributeMaxDynamicSharedMemorySize, LDS_BYTES) != hipSuccess) { fprintf(stderr, "kernel_launch: hipFuncSetAttribute failed\n"); grid = -1; return; }
    if (hipOccupancyMaxActiveBlocksPerMultiprocessor(&per_cu, (const void*)mega, 512, LDS_BYTES) != hipSuccess || per_cu < 1) { fprintf(stderr, "kernel_launch: occupancy query gave %d\n", per_cu); per_cu = 1; }
    (void)hipGetLastError();
    if (cus < 256) { fprintf(stderr, "kernel_launch: built for a 256-CU device, found %d CUs\n", cus); grid = -1; return; }
    grid = 256;
    fprintf(stderr, "kernel_launch: cus %d per_cu %d grid %d\n", cus, per_cu, grid);
  }
  if (grid < 0) return;
  if (hipMemsetAsync((char*)d_ws + WS_BAR, 0, 16384, stream) != hipSuccess) { fprintf(stderr, "kernel_launch: memset of the barrier words failed\n"); return; }
  Args a{};
  for (int i = 0; i < 12; ++i) a.in[i] = (const float*)d_in[i];
  a.out = (float*)d_out; a.ws = (unsigned char*)d_ws;
#if MK_ONE_LAUNCH
  a.ph_lo = 0; a.ph_hi = NPHASE;
  void* args[] = {&a};
  hipError_t e = hipLaunchCooperativeKernel((const void*)mega, dim3(grid), dim3(512), args, LDS_BYTES, stream);
  if (e != hipSuccess) fprintf(stderr, "kernel_launch: cooperative launch failed: %s (grid %d)\n", hipGetErrorString(e), grid);
#else
  for (int ph = 0; ph < NPHASE; ++ph) {
    a.ph_lo = ph; a.ph_hi = ph + 1;
    hipLaunchKernelGGL(mega, dim3(grid), dim3(512), LDS_BYTES, stream, a);
  }
#endif
}
```
